# Optimizing an MI355X kernel written in HIP

```python
import jax, jax.numpy as jnp
from jax import lax
import numpy as np

D_MODEL = 1024
BATCH = 4
SEQ = 4096
DEPTH = 2

N_MIXERS = 2
N_LRU_LAYERS = (DEPTH + 1) // 2
N_SB_LAYERS = DEPTH // 2
LRU_HEADS = max(4, D_MODEL // 64)
LRU_BLOCK = max(16, (((4 * D_MODEL) // 3) // LRU_HEADS) // 16 * 16)
LRU_WIDTH = LRU_HEADS * LRU_BLOCK
LRU_C = 8.0
CONV_WIDTH = 4
SB_HEAD_DIM = 64
SB_HEADS = max(4, D_MODEL // SB_HEAD_DIM)
SB_WIDTH = SB_HEADS * SB_HEAD_DIM
Q_BLOCK = 128
RMS_EPS = 1e-6

kernel_name = "hybrid_rglru_stickbreaking_trunk"


def rms_norm(x, g):
    xf = x.astype(jnp.float32)
    y = xf * lax.rsqrt(jnp.mean(xf * xf, axis=-1, keepdims=True) + RMS_EPS)
    return (y * g.astype(jnp.float32)).astype(x.dtype)


def causal_depthwise_conv(x, w, b):
    c = x.shape[-1]
    y = lax.conv_general_dilated(
        x, w[:, None, :].astype(x.dtype), window_strides=(1,),
        padding=[(CONV_WIDTH - 1, 0)], dimension_numbers=("NWC", "WIO", "NWC"),
        feature_group_count=c)
    return y + b.astype(x.dtype)


def _linear_recurrence_combine(left, right):
    a1, b1 = left
    a2, b2 = right
    return a1 * a2, a2 * b1 + b2


def rg_lru(x, w_gates, b_gates, lam):
    bsz, s, _ = x.shape
    xh = x.reshape(bsz, s, LRU_HEADS, LRU_BLOCK)
    gl = jnp.einsum("bshi,hio->bsho", xh, w_gates.astype(x.dtype)).astype(jnp.float32) + b_gates.astype(jnp.float32)
    r = jax.nn.sigmoid(gl[..., :LRU_BLOCK]).reshape(bsz, s, LRU_WIDTH)
    i = jax.nn.sigmoid(gl[..., LRU_BLOCK:]).reshape(bsz, s, LRU_WIDTH)
    log_a = LRU_C * r * jax.nn.log_sigmoid(lam.astype(jnp.float32))
    a = jnp.exp(log_a)
    mult = jnp.sqrt(-jnp.expm1(2.0 * log_a))
    bterm = mult * (i * x.astype(jnp.float32))
    _, h = lax.associative_scan(_linear_recurrence_combine, (a, bterm), axis=1)
    return h.astype(x.dtype)


def lru_mixer(h, w_in, conv_w, conv_b, w_gates, b_gates, lam, w_out):
    u = h @ w_in.astype(h.dtype)
    xb, gate = u[..., :LRU_WIDTH], u[..., LRU_WIDTH:]
    xb = causal_depthwise_conv(xb, conv_w, conv_b)
    y = rg_lru(xb, w_gates, b_gates, lam)
    return (y * jax.nn.silu(gate)) @ w_out.astype(h.dtype)


def stick_breaking_attention(q, k, v):
    s_len = q.shape[1]
    scale = SB_HEAD_DIM ** -0.5
    outs = []
    for qb in range(s_len // Q_BLOCK):
        t0 = qb * Q_BLOCK
        n_k = t0 + Q_BLOCK
        z = jnp.einsum("bthd,bshd->bhts", q[:, t0:n_k], k[:, :n_k]).astype(jnp.float32) * scale
        t_idx = t0 + jnp.arange(Q_BLOCK)[:, None]
        s_idx = jnp.arange(n_k)[None, :]
        causal = s_idx < t_idx
        log_beta = jax.nn.log_sigmoid(z)
        log_fail = jnp.where(causal, jax.nn.log_sigmoid(-z), 0.0)
        later = lax.cumsum(log_fail, axis=3, reverse=True) - log_fail
        att = jnp.where(causal, jnp.exp(log_beta + later), 0.0)
        outs.append(jnp.einsum("bhts,bshd->bthd", att.astype(v.dtype), v[:, :n_k]))
    return jnp.concatenate(outs, axis=1)


def sb_mixer(h, w_in, w_out):
    bsz, s, _ = h.shape
    u = h @ w_in.astype(h.dtype)
    q = u[..., :SB_WIDTH].reshape(bsz, s, SB_HEADS, SB_HEAD_DIM)
    k = u[..., SB_WIDTH:2 * SB_WIDTH].reshape(bsz, s, SB_HEADS, SB_HEAD_DIM)
    v = u[..., 2 * SB_WIDTH:3 * SB_WIDTH].reshape(bsz, s, SB_HEADS, SB_HEAD_DIM)
    gate = u[..., 3 * SB_WIDTH:]
    o = stick_breaking_attention(q, k, v).reshape(bsz, s, SB_WIDTH)
    return (o * jax.nn.silu(gate)) @ w_out.astype(h.dtype)


def setup_inputs(seed: int = 0) -> dict:
    key = jax.random.key(seed)
    ks = jax.random.split(key, 12)
    f32 = jnp.float32
    x = jax.random.normal(ks[0], (BATCH, SEQ, D_MODEL), f32)
    norm_g = 1.0 + 0.02 * jax.random.normal(ks[1], (DEPTH, D_MODEL), f32)
    final_norm_g = 1.0 + 0.02 * jax.random.normal(ks[2], (D_MODEL,), f32)
    lru_w_in = jax.random.normal(ks[3], (N_LRU_LAYERS, D_MODEL, 2 * LRU_WIDTH), f32) * D_MODEL ** -0.5
    lru_conv_w = jax.random.normal(ks[4], (N_LRU_LAYERS, CONV_WIDTH, LRU_WIDTH), f32) * CONV_WIDTH ** -0.5
    lru_conv_b = 0.01 * jax.random.normal(ks[5], (N_LRU_LAYERS, LRU_WIDTH), f32)
    lru_w_gates = jax.random.normal(ks[6], (N_LRU_LAYERS, LRU_HEADS, LRU_BLOCK, 2 * LRU_BLOCK), f32) * LRU_BLOCK ** -0.5
    lru_b_gates = 0.01 * jax.random.normal(ks[7], (N_LRU_LAYERS, LRU_HEADS, 2 * LRU_BLOCK), f32)
    u = jax.random.uniform(ks[8], (N_LRU_LAYERS, LRU_WIDTH), f32, minval=0.9, maxval=0.999)
    a0 = u ** (1.0 / LRU_C)
    lru_lambda = jnp.log(a0) - jnp.log1p(-a0)
    lru_w_out = jax.random.normal(ks[9], (N_LRU_LAYERS, LRU_WIDTH, D_MODEL), f32) * LRU_WIDTH ** -0.5
    sb_w_in = jax.random.normal(ks[10], (N_SB_LAYERS, D_MODEL, 4 * SB_WIDTH), f32) * D_MODEL ** -0.5
    sb_w_out = jax.random.normal(ks[11], (N_SB_LAYERS, SB_WIDTH, D_MODEL), f32) * SB_WIDTH ** -0.5
    return {"x": x, "norm_g": norm_g, "final_norm_g": final_norm_g,
            "lru_w_in": lru_w_in, "lru_conv_w": lru_conv_w, "lru_conv_b": lru_conv_b,
            "lru_w_gates": lru_w_gates, "lru_b_gates": lru_b_gates, "lru_lambda": lru_lambda,
            "lru_w_out": lru_w_out, "sb_w_in": sb_w_in, "sb_w_out": sb_w_out}


def reference(x, norm_g, final_norm_g, lru_w_in, lru_conv_w, lru_conv_b, lru_w_gates,
              lru_b_gates, lru_lambda, lru_w_out, sb_w_in, sb_w_out):
    for layer in range(DEPTH):
        h = rms_norm(x, norm_g[layer])
        j = layer // N_MIXERS
        if layer % N_MIXERS == 0:
            y = lru_mixer(h, lru_w_in[j], lru_conv_w[j], lru_conv_b[j], lru_w_gates[j],
                          lru_b_gates[j], lru_lambda[j], lru_w_out[j])
        else:
            y = sb_mixer(h, sb_w_in[j], sb_w_out[j])
        x = x + y
    return rms_norm(x, final_norm_g)
```

```cpp
#include <hip/hip_runtime.h>
#include <hip/hip_cooperative_groups.h>
#include <cstdio>
#include <cstdint>
namespace cg = cooperative_groups;
namespace pg8 {
#define PG8_LAS __attribute__((address_space(3)))
typedef unsigned short bf16_t;
typedef short bf16x8 __attribute__((ext_vector_type(8)));
typedef float f32x4 __attribute__((ext_vector_type(4)));
typedef unsigned u32x4 __attribute__((ext_vector_type(4)));
constexpr int BM = 256, BK = 64, HALF = 128, HTB = HALF * BK * 2  , STAGE_BYTES = 8 * HTB, NXCD = 8, WGM = 8;

__host__ __device__ __forceinline__ int lds_byte(int r, int c) { const int st = (r >> 4) * 2 + (c >> 5), rr = r & 15, cc = c & 31, ob = rr * 64 + cc * 2; return st * 1024 + (ob ^ (((ob >> 9) & 1) << 5)); }
__host__ __device__ __forceinline__ void stage_rc(int b, int& R, int& C) { const int st = b / 1024, sb = b % 1024, swz = sb ^ (((sb >> 9) & 1) << 5); R = (st >> 1) * 16 + swz / 64; C = (st & 1) * 32 + (swz % 64) / 2; }
__host__ __device__ __forceinline__ int perm32(int rho) { const int n = rho >> 4, i = rho & 15; return 8 * (i >> 2) + 4 * n + (i & 3); }

struct Unit { int pm, pn; };
struct Gemm { const bf16_t* A; const bf16_t* Bt; int M, N, K; };

struct StaticOrder {
    int nM, nN, nwg, G, c;
    __host__ __device__ void init(int M, int N, int G_, int c_) { nM = M / BM; nN = N / BM; nwg = nM * nN; G = G_; c = c_; }
    __host__ __device__ bool next(int i, Unit& u) const {
        const long L = (long)i * G + c; if (L >= nwg) return false;
        int wgid = (int)L; { const int q = nwg / NXCD, r = nwg % NXCD, xcd = wgid % NXCD, off = wgid / NXCD; wgid = (xcd < r ? xcd * (q + 1) : r * (q + 1) + (xcd - r) * q) + off; }
        const int nig = WGM * nN, gid = wgid / nig, fm = gid * WGM, gsz = (nM - fm) < WGM ? (nM - fm) : WGM;
        u.pm = fm + ((wgid % nig) % gsz); u.pn = (wgid % nig) / gsz; return true;
    }
    __device__ __forceinline__ void a_ready(const Unit&) const {}
    __device__ __forceinline__ void done(const Unit&) const {}
};

__device__ __forceinline__ unsigned cvt_pk_bf16(float lo, float hi) { unsigned r; asm volatile("v_cvt_pk_bf16_f32 %0, %1, %2" : "=v"(r) : "v"(lo), "v"(hi)); return r; }
typedef float f32x2 __attribute__((ext_vector_type(2)));
struct EpiRowScale {
    static constexpr bool PERM = true, AFTER_DRAIN = false;
    bf16_t* O; int ldc; const float* ssq; int qcols; float qscale;
    __device__ __forceinline__ void operator()(const f32x4 (&acc)[2][2][4][2], const Unit& u, int wr, int wc, int fr, int fq) const {
        const int row0 = u.pm * BM + wr * 64 + fr, colt = u.pn * BM;
        const float sc = (colt < qcols) ? qscale : 1.f;
        const int col0 = colt + wc * 32 + 8 * fq;
#pragma unroll
        for (int ai = 0; ai < 2; ++ai)
#pragma unroll
            for (int m = 0; m < 4; ++m) { const int row = row0 + ai * HALF + m * 16;
                const float rs = __builtin_amdgcn_rsqf(ssq[row] * (1.0f / 1024.0f) + 1e-6f) * sc;
                bf16_t* rowp = O + (size_t)row * ldc + col0;
#pragma unroll
                for (int bj = 0; bj < 2; ++bj) { const f32x4 v0 = acc[ai][bj][m][0] * rs, v1 = acc[ai][bj][m][1] * rs;
                    u32x4 w; w.x = cvt_pk_bf16(v0[0], v0[1]); w.y = cvt_pk_bf16(v0[2], v0[3]); w.z = cvt_pk_bf16(v1[0], v1[1]); w.w = cvt_pk_bf16(v1[2], v1[3]);
                    *(u32x4*)(rowp + bj * HALF) = w; } }
    }
};
struct EpiColScale {
    static constexpr bool PERM = true, AFTER_DRAIN = false;
    bf16_t* O; int ldc; const float* ssq;
    __device__ __forceinline__ void operator()(const f32x4 (&acc)[2][2][4][2], const Unit& u, int wr, int wc, int fr, int fq) const {
        const int row0 = u.pm * BM + wr * 64 + fr, col0 = u.pn * BM + wc * 32 + 8 * fq;
        f32x4 cs[2][2];
#pragma unroll
        for (int bj = 0; bj < 2; ++bj)
#pragma unroll
            for (int n = 0; n < 2; ++n) { const f32x4 q = *(const f32x4*)(ssq + col0 + bj * HALF + 4 * n);
#pragma unroll
                for (int e = 0; e < 4; ++e) cs[bj][n][e] = __builtin_amdgcn_rsqf(q[e] * (1.0f / 1024.0f) + 1e-6f); }
#pragma unroll
        for (int ai = 0; ai < 2; ++ai)
#pragma unroll
            for (int m = 0; m < 4; ++m) { bf16_t* rowp = O + (size_t)(row0 + ai * HALF + m * 16) * ldc + col0;
#pragma unroll
                for (int bj = 0; bj < 2; ++bj) { const f32x4 v0 = acc[ai][bj][m][0] * cs[bj][0], v1 = acc[ai][bj][m][1] * cs[bj][1];
                    u32x4 w; w.x = cvt_pk_bf16(v0[0], v0[1]); w.y = cvt_pk_bf16(v0[2], v0[3]); w.z = cvt_pk_bf16(v1[0], v1[1]); w.w = cvt_pk_bf16(v1[2], v1[3]);
                    *(u32x4*)(rowp + bj * HALF) = w; } }
    }
};
template <bool WB> struct EpiResid {
    static constexpr bool PERM = false, AFTER_DRAIN = false;
    const float* base; float* out; bf16_t* outb; float* ssq; int ldc;
    __device__ __forceinline__ void operator()(const f32x4 (&acc)[2][2][4][2], const Unit& u, int wr, int wc, int fr, int fq) const {
        const int row0 = u.pm * BM + wr * 64 + fr, col0 = u.pn * BM + wc * 32 + 4 * fq;
#pragma unroll
        for (int ai = 0; ai < 2; ++ai)
#pragma unroll
            for (int m = 0; m < 4; ++m) { const int row = row0 + ai * HALF + m * 16; const size_t off = (size_t)row * ldc + col0; float s = 0.f;
#pragma unroll
                for (int bj = 0; bj < 2; ++bj)
#pragma unroll
                    for (int n = 0; n < 2; ++n) { const f32x4 bs = *(const f32x4*)(base + off + bj * HALF + n * 16); const f32x4 v = bs + acc[ai][bj][m][n];
                        *(f32x4*)(out + off + bj * HALF + n * 16) = v; s += (v[0] * v[0] + v[1] * v[1]) + (v[2] * v[2] + v[3] * v[3]);
                        if (WB) { unsigned lo = cvt_pk_bf16(v[0], v[1]), hi = cvt_pk_bf16(v[2], v[3]); *(unsigned long long*)(outb + off + bj * HALF + n * 16) = (unsigned long long)lo | ((unsigned long long)hi << 32); } }
                s += __shfl_xor(s, 16); s += __shfl_xor(s, 32);
                if (fq == 0) atomicAdd(ssq + row, s);
                asm volatile("" ::: "memory"); }
    }
};
template <class Epi, class Sched, bool ALIGN_EPI = false, bool SP2 = false>
__device__ __forceinline__ void gemm_phase(PG8_LAS unsigned char* lds, const Gemm g, const Sched& S, const Epi& E) {
    const int tid = threadIdx.x, wid = __builtin_amdgcn_readfirstlane(tid >> 6), lane = tid & 63, wr = wid >> 2, wc = wid & 3, fr = lane & 15, fq = lane >> 4;
    const int K = g.K, nt = K / BK;
    unsigned voffA[2], voffB[2];
#pragma unroll
    for (int i = 0; i < 2; ++i) { int R, C; stage_rc(tid * 16 + i * 8192, R, C); const int Rb = Epi::PERM ? ((R & ~31) + perm32(R & 31)) : R;
        voffA[i] = (unsigned)(R * K + C) * 2u; voffB[i] = (unsigned)(Rb * K + C) * 2u; }
    const size_t kstep = (size_t)(BK * 2);
    const size_t hstep = (size_t)HALF * K * 2;
    const size_t tstep = 2 * hstep;
    const unsigned ldsw = (unsigned)wid * 1024u;
    const int aoff = lds_byte(wr * 64 + fr, fq * 8), boff = lds_byte(wc * 32 + fr, fq * 8);
#define PG8_SA(b, h) (((b) * 2 + (h)) * HTB)
#define PG8_SB(b, h) ((4 + (b) * 2 + (h)) * HTB)
#define PG8_STAGE(bufoff, gbase, voff) do { _Pragma("unroll") for (int _i = 0; _i < 2; ++_i) \
        __builtin_amdgcn_global_load_lds((const unsigned*)((const char*)(gbase) + (voff)[_i]), (PG8_LAS unsigned*)(lds + (bufoff) + ldsw + _i * 8192), 16, 0, 0); } while (0)
#define PG8_LDA(dst, b, h) do { _Pragma("unroll") for (int m = 0; m < 4; ++m) _Pragma("unroll") for (int k = 0; k < 2; ++k) dst[m][k] = *(const PG8_LAS bf16x8*)(lds + PG8_SA(b, h) + aoff + m * 2048 + k * 1024); } while (0)
#define PG8_LDB(dst, b, h) do { _Pragma("unroll") for (int n = 0; n < 2; ++n) _Pragma("unroll") for (int k = 0; k < 2; ++k) dst[n][k] = *(const PG8_LAS bf16x8*)(lds + PG8_SB(b, h) + boff + n * 2048 + k * 1024); } while (0)
#define PG8_MMA(ai, bj, At, Bt) do { __builtin_amdgcn_s_setprio(1); _Pragma("unroll") for (int m = 0; m < 4; ++m) _Pragma("unroll") for (int n = 0; n < 2; ++n) _Pragma("unroll") for (int k = 0; k < 2; ++k) \
        acc[ai][bj][m][n] = __builtin_amdgcn_mfma_f32_16x16x32_bf16(Bt[n][k], At[m][k], acc[ai][bj][m][n], 0, 0, 0); __builtin_amdgcn_s_setprio(0); } while (0)
#define PG8_WAIT_V(n) asm volatile("s_waitcnt vmcnt(" #n ")" ::: "memory")
#define PG8_WAIT_L(n) asm volatile("s_waitcnt lgkmcnt(" #n ")" ::: "memory")
#define PG8_BAR __builtin_amdgcn_s_barrier()
#define PG8_SCHED __builtin_amdgcn_sched_barrier(0)
    Unit cur, nxt; int ui = 0;
    if (!S.next(0, cur)) return;
    f32x4 acc[2][2][4][2];
#pragma unroll
    for (int a = 0; a < 2; ++a)
#pragma unroll
        for (int b = 0; b < 2; ++b)
#pragma unroll
            for (int m = 0; m < 4; ++m)
#pragma unroll
                for (int n = 0; n < 2; ++n) acc[a][b][m][n] = (f32x4){0.f, 0.f, 0.f, 0.f};
    bf16x8 At[4][2], B0[2][2], B1[2][2];
    const char* cA = (const char*)g.A + (size_t)cur.pm * tstep; const char* cB = (const char*)g.Bt + (size_t)cur.pn * tstep;
    S.a_ready(cur);
    if constexpr (SP2) {
        PG8_STAGE(PG8_SB(0, 0), cB, voffB); PG8_STAGE(PG8_SB(0, 1), cB + hstep, voffB); PG8_STAGE(PG8_SA(0, 0), cA, voffA); PG8_STAGE(PG8_SA(0, 1), cA + hstep, voffA);
        if (wr == 1) PG8_BAR;
        PG8_WAIT_V(2); PG8_BAR;
        PG8_STAGE(PG8_SB(1, 0), cB + kstep, voffB); PG8_STAGE(PG8_SA(1, 0), cA + kstep, voffA); PG8_STAGE(PG8_SB(1, 1), cB + hstep + kstep, voffB);
        PG8_WAIT_V(6); PG8_BAR;
    } else {
        PG8_STAGE(PG8_SB(0, 0), cB, voffB); PG8_STAGE(PG8_SA(0, 0), cA, voffA); PG8_STAGE(PG8_SB(0, 1), cB + hstep, voffB); PG8_STAGE(PG8_SA(0, 1), cA + hstep, voffA);
        if (wr == 1) PG8_BAR;
        PG8_WAIT_V(4); PG8_BAR;
        PG8_STAGE(PG8_SB(1, 0), cB + kstep, voffB); PG8_STAGE(PG8_SA(1, 0), cA + kstep, voffA); PG8_STAGE(PG8_SB(1, 1), cB + hstep + kstep, voffB);
        PG8_WAIT_V(6); PG8_BAR;
    }
    for (;;) {
        const bool has_next = S.next(ui + 1, nxt);
        const char* nA = has_next ? (const char*)g.A + (size_t)nxt.pm * tstep : cA; const char* nB = has_next ? (const char*)g.Bt + (size_t)nxt.pn * tstep : cB;
        for (int t = 0; t < nt; t += 2) {
            const bool last = (t == nt - 2);
            const char* a1 = cA + (size_t)(t + 1) * kstep;
            const char* a2 = last ? nA : cA + (size_t)(t + 2) * kstep; const char* b2 = last ? nB : cB + (size_t)(t + 2) * kstep;
            const char* a3 = a2 + kstep; const char* b3 = b2 + kstep;
            if (last && has_next) S.a_ready(nxt);
            if constexpr (SP2) {
            PG8_LDB(B0, 0, 0); PG8_LDB(B1, 0, 1); PG8_SCHED; PG8_LDA(At, 0, 0); PG8_STAGE(PG8_SA(1, 1), a1 + hstep, voffA);
            PG8_WAIT_V(8); PG8_WAIT_L(0); PG8_BAR; PG8_MMA(0, 0, At, B0); PG8_MMA(0, 1, At, B1); PG8_BAR; PG8_SCHED;
            PG8_LDA(At, 0, 1); PG8_STAGE(PG8_SB(0, 0), b2, voffB); PG8_STAGE(PG8_SB(0, 1), b2 + hstep, voffB); PG8_STAGE(PG8_SA(0, 0), a2, voffA);
            PG8_WAIT_V(8); PG8_WAIT_L(0); PG8_BAR; PG8_MMA(1, 0, At, B0); PG8_MMA(1, 1, At, B1); PG8_BAR; PG8_SCHED;
            PG8_LDB(B0, 1, 0); PG8_LDB(B1, 1, 1); PG8_SCHED; PG8_LDA(At, 1, 0); PG8_STAGE(PG8_SA(0, 1), a2 + hstep, voffA);
            PG8_WAIT_V(8); PG8_WAIT_L(0); PG8_BAR; PG8_MMA(0, 0, At, B0); PG8_MMA(0, 1, At, B1); PG8_BAR; PG8_SCHED;
            PG8_LDA(At, 1, 1); PG8_STAGE(PG8_SB(1, 0), b3, voffB); PG8_STAGE(PG8_SB(1, 1), b3 + hstep, voffB); PG8_STAGE(PG8_SA(1, 0), a3, voffA);
            PG8_WAIT_V(8); PG8_WAIT_L(0); PG8_BAR; PG8_MMA(1, 0, At, B0); PG8_MMA(1, 1, At, B1); PG8_BAR; PG8_SCHED;
            } else {
            PG8_LDB(B0, 0, 0); PG8_SCHED; PG8_LDA(At, 0, 0); PG8_STAGE(PG8_SA(1, 1), a1 + hstep, voffA);
            PG8_WAIT_L(8); PG8_BAR; PG8_WAIT_L(0); PG8_MMA(0, 0, At, B0); PG8_BAR; PG8_SCHED;
            PG8_LDB(B1, 0, 1); PG8_STAGE(PG8_SB(0, 0), b2, voffB);
            PG8_BAR; PG8_WAIT_L(0); PG8_MMA(0, 1, At, B1); PG8_BAR;
            PG8_LDA(At, 0, 1); PG8_STAGE(PG8_SA(0, 0), a2, voffA);
            PG8_BAR; PG8_WAIT_L(0); PG8_MMA(1, 0, At, B0); PG8_BAR; PG8_SCHED;
            PG8_STAGE(PG8_SB(0, 1), b2 + hstep, voffB);
            PG8_WAIT_V(6); PG8_BAR; PG8_MMA(1, 1, At, B1); PG8_BAR;
            PG8_LDB(B0, 1, 0); PG8_SCHED; PG8_LDA(At, 1, 0); PG8_STAGE(PG8_SA(0, 1), a2 + hstep, voffA);
            PG8_WAIT_L(8); PG8_BAR; PG8_WAIT_L(0); PG8_MMA(0, 0, At, B0); PG8_BAR; PG8_SCHED;
            PG8_LDB(B1, 1, 1); PG8_STAGE(PG8_SB(1, 0), b3, voffB);
            PG8_BAR; PG8_WAIT_L(0); PG8_MMA(0, 1, At, B1); PG8_BAR;
            PG8_LDA(At, 1, 1); PG8_STAGE(PG8_SA(1, 0), a3, voffA);
            PG8_BAR; PG8_WAIT_L(0); PG8_MMA(1, 0, At, B0); PG8_BAR; PG8_SCHED;
            PG8_STAGE(PG8_SB(1, 1), b3 + hstep, voffB);
            PG8_WAIT_V(6); PG8_BAR; PG8_MMA(1, 1, At, B1); PG8_BAR;
            }
        }
        if constexpr (ALIGN_EPI) { if (wr == 0) PG8_BAR; }
        if constexpr (!Epi::AFTER_DRAIN) { E(acc, cur, wr, wc, fr, fq); S.done(cur); }
        if (!has_next) break;
#pragma unroll
        for (int a = 0; a < 2; ++a)
#pragma unroll
            for (int b = 0; b < 2; ++b)
#pragma unroll
                for (int m = 0; m < 4; ++m)
#pragma unroll
                    for (int n = 0; n < 2; ++n) acc[a][b][m][n] = (f32x4){0.f, 0.f, 0.f, 0.f};
        cur = nxt; cA = nA; cB = nB; ++ui;
        if constexpr (ALIGN_EPI) { if (wr == 1) PG8_BAR; }
    }
    PG8_WAIT_V(0);
    if constexpr (!ALIGN_EPI) { if (wr == 0) PG8_BAR; }
    PG8_BAR;
    if constexpr (Epi::AFTER_DRAIN) { E.fused(acc, cur, wr, wc, fr, fq, lds, wid, lane); S.done(cur); }
#undef PG8_SA
#undef PG8_SB
#undef PG8_STAGE
#undef PG8_LDA
#undef PG8_LDB
#undef PG8_MMA
#undef PG8_WAIT_V
#undef PG8_WAIT_L
#undef PG8_BAR
#undef PG8_SCHED
}
}
#define LAS __attribute__((address_space(3)))
typedef unsigned short bf16;
typedef unsigned v4u __attribute__((ext_vector_type(4)));
typedef unsigned v2u __attribute__((ext_vector_type(2)));
typedef float f32x4 __attribute__((ext_vector_type(4)));
typedef float f32x16 __attribute__((ext_vector_type(16)));
typedef short bf16x8 __attribute__((ext_vector_type(8)));
typedef float f32x2_t __attribute__((ext_vector_type(2))); typedef __bf16 bf16x2_t __attribute__((ext_vector_type(2)));
constexpr int NWAVES = 8, NT = 512;
constexpr int BATCH = 4, SEQ = 4096, D = 1024, M = BATCH * SEQ;
constexpr int LH = 16, LB = 80, LW = 1280;
constexpr int NIN0 = 2 * LW;
constexpr int AH = 16, HD = 64, AW = 1024, NIN1 = 4 * AW;
constexpr int NQKG = 3 * AW;
constexpr int CHUNK = 256, NCHUNK = SEQ / CHUNK;
constexpr float LOG2E = 1.4426950408889634f, LN2 = 0.6931471805599453f;
constexpr float QSCALE = 0.125f * LOG2E;
constexpr size_t MiB = 1u << 20;
constexpr size_t WS_SSQ0 = 1 * MiB, WS_SSQ1 = WS_SSQ0 + 65536, WS_SSQ2 = WS_SSQ1 + 65536, WS_SUM = WS_SSQ2 + 65536;
constexpr size_t WS_PAR = WS_SUM + 655360;
constexpr size_t WS_W0T = 2 * MiB, WS_WO0T = 8 * MiB, WS_W1T = 11 * MiB, WS_WO1T = 20 * MiB, WS_WGF = 22 * MiB;
constexpr size_t WS_XB = 24 * MiB;
constexpr size_t WS_U0 = 56 * MiB;
constexpr size_t WS_YG = 140 * MiB;
constexpr size_t WS_U1 = 56 * MiB;
constexpr size_t WS_VT = 156 * MiB;
constexpr size_t WS_OG = 188 * MiB;
constexpr size_t WS_END = 220 * MiB;
static_assert(WS_PAR + 40960 <= WS_W0T && WS_U0 + (size_t)M * NIN0 * 2 <= WS_YG && WS_YG + (size_t)M * LW * 2 <= WS_OG && WS_U1 + (size_t)M * NQKG * 2 <= WS_VT && WS_VT + (size_t)M * AW * 2 <= WS_OG, "ws map");
constexpr int LDS_BYTES = 135168;

__device__ __forceinline__ unsigned pk2(float lo, float hi) { f32x2_t v = {lo, hi}; bf16x2_t b = __builtin_convertvector(v, bf16x2_t); return __builtin_bit_cast(unsigned, b); }
__device__ __forceinline__ float bflo(unsigned u) { return __uint_as_float(u << 16); }
__device__ __forceinline__ float bfhi(unsigned u) { return __uint_as_float(u & 0xffff0000u); }
__device__ __forceinline__ float ex2(float x) { return __builtin_amdgcn_exp2f(x); }
__device__ __forceinline__ float rcpf_(float x) { return __builtin_amdgcn_rcpf(x); }
__device__ __forceinline__ float sigmoid_(float x) { return rcpf_(1.0f + ex2(-LOG2E * x)); }
__device__ __forceinline__ float wave_sum(float v) {
#pragma unroll
    for (int o = 1; o < 64; o <<= 1) v += __shfl_xor(v, o);
    return v;
}
#define LDS_WAIT() asm volatile("s_waitcnt lgkmcnt(0)" ::: "memory")
#define MFMA32(a, b, c) __builtin_amdgcn_mfma_f32_32x32x16_bf16((a), (b), (c), 0, 0, 0)
__device__ __forceinline__ int crow(int reg, int h) { return (reg & 3) + 8 * (reg >> 2) + 4 * h; }

__device__ __forceinline__ void p0_transpose_item(const float* W, int K, int N, bf16* WT, const float* ks, int radd, LAS float* scr, int kb, int nb, int lane) {
    const int k0 = 64 * kb, n0 = 32 * nb;
#pragma unroll 8
    for (int i = 0; i < 32; ++i) { const int kk = 2 * i + (lane >> 5); const float s = ks ? ks[k0 + kk] : 1.0f; scr[kk * 33 + (lane & 31)] = W[(size_t)(k0 + kk) * N + n0 + (lane & 31)] * s; }
    LDS_WAIT(); asm volatile("" ::: "memory");
    const int c = lane & 7;
#pragma unroll
    for (int j = 0; j < 4; ++j) { const int n = (lane >> 3) + 8 * j; const LAS float* s = scr + (8 * c) * 33 + n;
        v4u o; o.x = pk2(s[0 * 33], s[1 * 33]); o.y = pk2(s[2 * 33], s[3 * 33]); o.z = pk2(s[4 * 33], s[5 * 33]); o.w = pk2(s[6 * 33], s[7 * 33]);
        *(v4u*)(WT + (size_t)(radd + n0 + n) * K + k0 + 8 * c) = o; }
    LDS_WAIT(); asm volatile("" ::: "memory");
}
struct Ptrs {
    const float *x, *norm_g, *fng, *lwin, *lcw, *lcb, *lwg, *lbg, *llam, *lwout, *swin, *swout;
    float* out; unsigned char* ws;
};
__device__ __forceinline__ void p0_prologue(const Ptrs& P, LAS unsigned char* lds, int gw, int NGW, int wave, int lane, int gtid, int GT) {
    LAS float* scr = (LAS float*)(lds + wave * 16384);
    bf16* W0T = (bf16*)(P.ws + WS_W0T); bf16* WO0T = (bf16*)(P.ws + WS_WO0T); bf16* W1T = (bf16*)(P.ws + WS_W1T); bf16* WO1T = (bf16*)(P.ws + WS_WO1T);
    constexpr int I0 = (D / 64) * (NIN0 / 32), I1 = (LW / 64) * (D / 32), I2 = (D / 64) * (NIN1 / 32), I3 = (AW / 64) * (D / 32);
    for (int it = gw; it < I0 + I1 + I2 + I3; it += NGW) {
        int r = it;
        if (r < I0) { const int nblk = NIN0 / 32; p0_transpose_item(P.lwin, D, NIN0, W0T, P.norm_g, 0, scr, r / nblk, r % nblk, lane); continue; } r -= I0;
        if (r < I1) { const int nblk = D / 32; p0_transpose_item(P.lwout, LW, D, WO0T, nullptr, 0, scr, r / nblk, r % nblk, lane); continue; } r -= I1;
        if (r < I2) { const int nblk = NIN1 / 32, nb = r % nblk, n0 = 32 * nb;
            const int radd = (n0 < 2 * AW) ? 0 : (n0 < 3 * AW ? AW : -AW);
            p0_transpose_item(P.swin, D, NIN1, W1T, P.norm_g + D, radd, scr, r / nblk, nb, lane); continue; } r -= I2;
        { const int nblk = D / 32; p0_transpose_item(P.swout, AW, D, WO1T, nullptr, 0, scr, r / nblk, r % nblk, lane); }
    }
    bf16* WGF = (bf16*)(P.ws + WS_WGF);
    for (int g = gtid; g < LH * 6 * 5 * 64; g += GT) {
        const int l = g & 63, s = (g >> 6) % 5, tile = (g / 320) % 6, hd = g / 1920, r = l & 31, hh = l >> 5;
        const int cc = 32 * (tile % 3) + r; float v[8];
#pragma unroll
        for (int j = 0; j < 8; ++j) { const int ch = 16 * s + 8 * (j >> 2) + 4 * hh + (j & 3);
            v[j] = (cc < LB) ? P.lwg[((size_t)hd * LB + ch) * (2 * LB) + (tile < 3 ? cc : LB + cc)] : 0.0f; }
        v4u o; o.x = pk2(v[0], v[1]); o.y = pk2(v[2], v[3]); o.z = pk2(v[4], v[5]); o.w = pk2(v[6], v[7]);
        *(v4u*)(WGF + (size_t)g * 8) = o;
    }
    float* PAR = (float*)(P.ws + WS_PAR);
    for (int g = gtid; g < LH * 8 * LB; g += GT) {
        const int ch = g % LB, row = (g / LB) % 8, hd = g / (8 * LB), c = hd * LB + ch; float v;
        if (row < 4) v = P.lcw[row * LW + c];
        else if (row == 4) v = P.lcb[c];
        else if (row == 5) v = P.lbg[hd * 2 * LB + ch];
        else if (row == 6) v = P.lbg[hd * 2 * LB + LB + ch];
        else { const float lam = P.llam[c]; v = 8.0f * LOG2E * (fminf(lam, 0.0f) - log1pf(expf(-fabsf(lam)))); }
        PAR[g] = v;
    }
    float* ssq0 = (float*)(P.ws + WS_SSQ0); float* ssq1 = (float*)(P.ws + WS_SSQ1); float* ssq2 = (float*)(P.ws + WS_SSQ2);
    for (int g = gtid; g < M; g += GT) { ssq1[g] = 0.0f; ssq2[g] = 0.0f; }
    bf16* XB = (bf16*)(P.ws + WS_XB);
    for (int m = gw; m < M; m += NGW) {
        const f32x4* xr = (const f32x4*)(P.x + (size_t)m * D) + lane; unsigned long long* o8 = (unsigned long long*)(XB + (size_t)m * D) + lane;
        f32x4 v[4]; float s = 0.f;
#pragma unroll
        for (int j = 0; j < 4; ++j) { v[j] = xr[64 * j]; s += (v[j].x * v[j].x + v[j].y * v[j].y) + (v[j].z * v[j].z + v[j].w * v[j].w); }
#pragma unroll
        for (int j = 0; j < 4; ++j) o8[64 * j] = (unsigned long long)pk2(v[j].x, v[j].y) | ((unsigned long long)pk2(v[j].z, v[j].w) << 32);
        s = wave_sum(s); if (lane == 0) ssq0[m] = s;
    }
}

template <int CTRL, int RMASK> __device__ __forceinline__ float dpp_f(float old, float src) {
    return __builtin_bit_cast(float, __builtin_amdgcn_update_dpp(__builtin_bit_cast(int, old), __builtin_bit_cast(int, src), CTRL, RMASK, 0xf, false));
}
constexpr int L_WGF = 0, L_PAR = 30720, L_COMP = 33280, L_HIN = 38400, L_SUM = 40960;
template <bool PASSB> __device__ __forceinline__ void lru_phase(const Ptrs& P, LAS unsigned char* lds, int G, int wave, int lane, int tid) {
    const bf16* U0 = (const bf16*)(P.ws + WS_U0); bf16* YG = (bf16*)(P.ws + WS_YG);
    const bf16* WGF = (const bf16*)(P.ws + WS_WGF); const float* PAR = (const float*)(P.ws + WS_PAR); float* SUM = (float*)(P.ws + WS_SUM);
    const int r = lane & 31, hh = lane >> 5;
    for (int u = blockIdx.x; u < 64 * NCHUNK; u += G) {
        const int bh = u & 63, c = u >> 6, b = bh >> 4, hd = bh & 15;
        { const v4u* src = (const v4u*)(WGF + (size_t)hd * 15360); LAS v4u* dst = (LAS v4u*)(lds + L_WGF);
          for (int i = tid; i < 1920; i += NT) dst[i] = src[i];
          const f32x4* ps = (const f32x4*)(PAR + hd * 640); LAS f32x4* pd = (LAS f32x4*)(lds + L_PAR);
          if (tid < 160) pd[tid] = ps[tid];
          if (PASSB) { const f32x4* ss = (const f32x4*)(SUM + (size_t)bh * NCHUNK * 160); LAS f32x4* sd = (LAS f32x4*)(lds + L_SUM);
              for (int i = tid; i < c * 40; i += NT) sd[i] = ss[i]; } }
        __syncthreads();
        const LAS float* par = (const LAS float*)(lds + L_PAR);
        const int tloc = c * CHUNK + wave * 32 + r; const size_t trow = (size_t)b * SEQ + tloc;
        float xc[5][2][4]; bf16x8 xf[5];
        { const bf16* up = U0 + trow * NIN0 + hd * LB + 4 * hh;
#pragma unroll
          for (int s = 0; s < 5; ++s) { unsigned pkd[4];
#pragma unroll
              for (int half = 0; half < 2; ++half) { const int ch0 = 16 * s + 8 * half;
                  const f32x4 cb = *(const LAS f32x4*)(par + 4 * LB + ch0 + 4 * hh);
                  float a0 = cb[0], a1 = cb[1], a2 = cb[2], a3 = cb[3];
#pragma unroll
                  for (int tap = 0; tap < 4; ++tap) { const bool ok = (tloc - 3 + tap) >= 0;
                      v2u raw = *(const v2u*)(up + (ok ? (ptrdiff_t)(tap - 3) * NIN0 : (ptrdiff_t)0) + ch0); raw.x = ok ? raw.x : 0u; raw.y = ok ? raw.y : 0u;
                      const f32x4 cw = *(const LAS f32x4*)(par + tap * LB + ch0 + 4 * hh);
                      a0 += cw[0] * bflo(raw.x); a1 += cw[1] * bfhi(raw.x); a2 += cw[2] * bflo(raw.y); a3 += cw[3] * bfhi(raw.y); }
                  asm volatile("" : "+v"(a0), "+v"(a1), "+v"(a2), "+v"(a3));
                  xc[s][half][0] = a0; xc[s][half][1] = a1; xc[s][half][2] = a2; xc[s][half][3] = a3;
                  pkd[2 * half] = pk2(a0, a1); pkd[2 * half + 1] = pk2(a2, a3); __builtin_amdgcn_sched_barrier(0); }
              v4u t = {pkd[0], pkd[1], pkd[2], pkd[3]}; xf[s] = __builtin_bit_cast(bf16x8, t); __builtin_amdgcn_sched_barrier(0); } }
        float Av[5][2][4];
#pragma unroll
        for (int mt = 0; mt < 3; ++mt) {
            f32x16 gr, gi;
#pragma unroll
            for (int i = 0; i < 16; ++i) { gr[i] = 0.f; gi[i] = 0.f; }
            const LAS bf16x8* wa = (const LAS bf16x8*)(lds + L_WGF) + (size_t)(mt * 5) * 64 + lane;
            const LAS bf16x8* wb = (const LAS bf16x8*)(lds + L_WGF) + (size_t)((3 + mt) * 5) * 64 + lane;
#pragma unroll
            for (int s = 0; s < 5; ++s) { gr = MFMA32(wa[s * 64], xf[s], gr); gi = MFMA32(wb[s * 64], xf[s], gi); }
            __builtin_amdgcn_sched_barrier(0);
#pragma unroll
            for (int i4 = 0; i4 < 4; ++i4) { if (mt == 2 && i4 >= 2) continue;
                const int s = 2 * mt + (i4 >> 1), half = i4 & 1, ch0 = 16 * s + 8 * half + 4 * hh;
                const f32x4 bgr = *(const LAS f32x4*)(par + 5 * LB + ch0), bgi = *(const LAS f32x4*)(par + 6 * LB + ch0), ls2 = *(const LAS f32x4*)(par + 7 * LB + ch0);
#pragma unroll
                for (int q = 0; q < 4; ++q) { const int i = 4 * i4 + q;
                    const float rg = sigmoid_(gr[i] + bgr[q]), ig = sigmoid_(gi[i] + bgi[q]);
                    const float la2 = ls2[q] * rg, a = ex2(la2), xx = (2.0f * LN2) * la2;
                    const float poly = -xx * (1.0f + xx * (0.5f + xx * ((1.0f / 6.0f) + xx * ((1.0f / 24.0f) + xx * ((1.0f / 120.0f) + xx * (1.0f / 720.0f))))));
                    const float om = (xx > -0.25f) ? poly : (1.0f - a * a);
                    const float bt = __builtin_sqrtf(om) * (ig * xc[s][half][q]);
                    Av[s][half][q] = a; xc[s][half][q] = bt; }
                asm volatile("" : "+v"(Av[s][half][0]), "+v"(Av[s][half][1]), "+v"(Av[s][half][2]), "+v"(Av[s][half][3]), "+v"(xc[s][half][0]), "+v"(xc[s][half][1]), "+v"(xc[s][half][2]), "+v"(xc[s][half][3]));
                __builtin_amdgcn_sched_barrier(0); }
        }
#pragma unroll
        for (int s = 0; s < 5; ++s)
#pragma unroll
            for (int half = 0; half < 2; ++half)
#pragma unroll
                for (int q = 0; q < 4; ++q) { float A = Av[s][half][q], Bv = xc[s][half][q];
#define LRU_STEP(CTRL, RMASK) { const float ap = dpp_f<CTRL, RMASK>(1.0f, A), bp = dpp_f<CTRL, RMASK>(0.0f, Bv); Bv = A * bp + Bv; A = A * ap; }
                    LRU_STEP(0x111, 0xf) LRU_STEP(0x112, 0xf) LRU_STEP(0x114, 0xf) LRU_STEP(0x118, 0xf) LRU_STEP(0x142, 0xa)
#undef LRU_STEP
                    asm volatile("" : "+v"(A), "+v"(Bv));
                    Av[s][half][q] = A; xc[s][half][q] = Bv; if (q == 3) __builtin_amdgcn_sched_barrier(0); }
        if (r == 31) { LAS float* cp = (LAS float*)(lds + L_COMP) + wave * 160 + 4 * hh;
#pragma unroll
            for (int s = 0; s < 5; ++s)
#pragma unroll
                for (int half = 0; half < 2; ++half) { const int ch0 = 16 * s + 8 * half;
                    *(LAS f32x4*)(cp + ch0) = (f32x4){Av[s][half][0], Av[s][half][1], Av[s][half][2], Av[s][half][3]};
                    *(LAS f32x4*)(cp + 80 + ch0) = (f32x4){xc[s][half][0], xc[s][half][1], xc[s][half][2], xc[s][half][3]}; } }
        __syncthreads();
        if (tid < LB) { const LAS float* cp = (const LAS float*)(lds + L_COMP) + tid;
            if (!PASSB) { float Au = 1.0f, Bu = 0.0f;
#pragma unroll
                for (int w = 0; w < 8; ++w) { const float a = cp[w * 160], bb = cp[w * 160 + 80]; Bu = a * Bu + bb; Au = Au * a; }
                float* so = SUM + ((size_t)bh * NCHUNK + c) * 160 + tid; so[0] = Au; so[80] = Bu;
            } else { const LAS float* sp = (const LAS float*)(lds + L_SUM) + tid; float h = 0.0f;
                for (int cc = 0; cc < c; ++cc) h = sp[cc * 160] * h + sp[cc * 160 + 80];
                LAS float* hp = (LAS float*)(lds + L_HIN) + tid;
#pragma unroll
                for (int w = 0; w < 8; ++w) { hp[w * 80] = h; h = cp[w * 160] * h + cp[w * 160 + 80]; } } }
        if (PASSB) {
            __syncthreads();
            const LAS float* hp = (const LAS float*)(lds + L_HIN) + wave * 80 + 4 * hh;
            const bf16* gp = U0 + trow * NIN0 + LW + hd * LB + 4 * hh; bf16* yp = YG + trow * LW + hd * LB + 4 * hh;
#pragma unroll
            for (int s = 0; s < 5; ++s)
#pragma unroll
                for (int half = 0; half < 2; ++half) { const int ch0 = 16 * s + 8 * half;
                    const f32x4 hin = *(const LAS f32x4*)(hp + ch0); const v2u graw = *(const v2u*)(gp + ch0);
                    const float g0 = bflo(graw.x), g1 = bfhi(graw.x), g2 = bflo(graw.y), g3 = bfhi(graw.y);
                    const float y0 = (xc[s][half][0] + Av[s][half][0] * hin[0]) * (g0 * sigmoid_(g0));
                    const float y1 = (xc[s][half][1] + Av[s][half][1] * hin[1]) * (g1 * sigmoid_(g1));
                    const float y2 = (xc[s][half][2] + Av[s][half][2] * hin[2]) * (g2 * sigmoid_(g2));
                    const float y3 = (xc[s][half][3] + Av[s][half][3] * hin[3]) * (g3 * sigmoid_(g3));
                    v2u o; o.x = pk2(y0, y1); o.y = pk2(y2, y3); *(v2u*)(yp + ch0) = o; __builtin_amdgcn_sched_barrier(0); }
        }
        __syncthreads();
    }
}
__device__ __forceinline__ void attn_phase(const Ptrs& P, int gw, int NGW, int lane) {
    const bf16* U1 = (const bf16*)(P.ws + WS_U1); const bf16* VT = (const bf16*)(P.ws + WS_VT); bf16* OG = (bf16*)(P.ws + WS_OG);
    const int r = lane & 31, hh = lane >> 5;
    for (int u = gw; u < BATCH * AH * (SEQ / 32); u += NGW) {
        const int qt = u & 127, bhh = u >> 7, b = bhh >> 4, h = bhh & 15;
        const size_t rowbase = (size_t)b * SEQ;
        bf16x8 qf[4], kf[4];
        { const bf16* qp = U1 + (rowbase + qt * 32 + r) * NQKG + h * HD + 8 * hh;
#pragma unroll
          for (int ks = 0; ks < 4; ++ks) qf[ks] = *(const bf16x8*)(qp + 16 * ks); }
        const bf16* kbase = U1 + rowbase * NQKG + AW + h * HD + 8 * hh;
        const bf16* vbase = VT + (size_t)(h * HD + r) * M + rowbase + 4 * hh;
        { const bf16* kp = kbase + (size_t)(qt * 32 + r) * NQKG;
#pragma unroll
          for (int ks = 0; ks < 4; ++ks) kf[ks] = *(const bf16x8*)(kp + 16 * ks); }
        f32x16 o0, o1;
#pragma unroll
        for (int i = 0; i < 16; ++i) { o0[i] = 0.f; o1[i] = 0.f; }
        float Pc = 1.0f;
        for (int kt = qt; kt >= 0; --kt) {
            v2u vf[2][2][2]; const bf16* vp = vbase + kt * 32;
#pragma unroll
            for (int dt = 0; dt < 2; ++dt)
#pragma unroll
                for (int s = 0; s < 2; ++s)
#pragma unroll
                    for (int half = 0; half < 2; ++half) vf[dt][s][half] = *(const v2u*)(vp + (size_t)dt * 32 * M + 16 * s + 8 * half);
            bf16x8 kn[4];
            { const int ktn = kt > 0 ? kt - 1 : 0; const bf16* kp = kbase + (size_t)(ktn * 32 + r) * NQKG;
#pragma unroll
              for (int ks = 0; ks < 4; ++ks) kn[ks] = *(const bf16x8*)(kp + 16 * ks); }
            f32x16 sa;
#pragma unroll
            for (int i = 0; i < 16; ++i) sa[i] = 0.f;
#pragma unroll
            for (int ks = 0; ks < 4; ++ks) sa = MFMA32(kf[ks], qf[ks], sa);
            float beta[16], f[16];
            const bool diag = (kt == qt);
#pragma unroll
            for (int i = 0; i < 16; ++i) { const float z = sa[i], e = ex2(-__builtin_fabsf(z)), rr = rcpf_(1.0f + e), er = e * rr; const bool pos = z >= 0.0f;
                float bt = pos ? rr : er, ff = pos ? er : rr;
                if (diag) { const bool valid = crow(i, hh) < r; bt = valid ? bt : 0.0f; ff = valid ? ff : 1.0f; }
                beta[i] = bt; f[i] = ff; }
            float gp[4], ot[4], pr[4];
#pragma unroll
            for (int g = 0; g < 4; ++g) { gp[g] = (f[4 * g] * f[4 * g + 1]) * (f[4 * g + 2] * f[4 * g + 3]); ot[g] = __shfl_xor(gp[g], 32); pr[g] = gp[g] * ot[g]; }
            float suf = Pc; float att[16];
#pragma unroll
            for (int g = 3; g >= 0; --g) { float p = (hh == 0) ? suf * ot[g] : suf;
                att[4 * g + 3] = beta[4 * g + 3] * p; p *= f[4 * g + 3];
                att[4 * g + 2] = beta[4 * g + 2] * p; p *= f[4 * g + 2];
                att[4 * g + 1] = beta[4 * g + 1] * p; p *= f[4 * g + 1];
                att[4 * g] = beta[4 * g] * p;
                suf *= pr[g]; }
            Pc = suf;
            bf16x8 pf[2];
#pragma unroll
            for (int s = 0; s < 2; ++s) { v4u t; t.x = pk2(att[8 * s], att[8 * s + 1]); t.y = pk2(att[8 * s + 2], att[8 * s + 3]); t.z = pk2(att[8 * s + 4], att[8 * s + 5]); t.w = pk2(att[8 * s + 6], att[8 * s + 7]); pf[s] = __builtin_bit_cast(bf16x8, t); }
#pragma unroll
            for (int s = 0; s < 2; ++s) { v4u a0 = {vf[0][s][0].x, vf[0][s][0].y, vf[0][s][1].x, vf[0][s][1].y}, a1 = {vf[1][s][0].x, vf[1][s][0].y, vf[1][s][1].x, vf[1][s][1].y};
                o0 = MFMA32(__builtin_bit_cast(bf16x8, a0), pf[s], o0); o1 = MFMA32(__builtin_bit_cast(bf16x8, a1), pf[s], o1); }
#pragma unroll
            for (int ks = 0; ks < 4; ++ks) kf[ks] = kn[ks];
            if (__builtin_amdgcn_ballot_w64(Pc != 0.0f) == 0ull) break;
        }
        const size_t row = rowbase + qt * 32 + r;
        const bf16* gp_ = U1 + row * NQKG + 2 * AW + h * HD + 4 * hh; bf16* op = OG + row * AW + h * HD + 4 * hh;
#pragma unroll
        for (int dt = 0; dt < 2; ++dt)
#pragma unroll
            for (int g = 0; g < 4; ++g) { const v2u graw = *(const v2u*)(gp_ + dt * 32 + 8 * g);
                const float g0 = bflo(graw.x), g1 = bfhi(graw.x), g2 = bflo(graw.y), g3 = bfhi(graw.y);
                const float v0 = dt ? o1[4 * g] : o0[4 * g], v1 = dt ? o1[4 * g + 1] : o0[4 * g + 1], v2 = dt ? o1[4 * g + 2] : o0[4 * g + 2], v3 = dt ? o1[4 * g + 3] : o0[4 * g + 3];
                v2u o; o.x = pk2(v0 * (g0 * sigmoid_(g0)), v1 * (g1 * sigmoid_(g1))); o.y = pk2(v2 * (g2 * sigmoid_(g2)), v3 * (g3 * sigmoid_(g3)));
                *(v2u*)(op + dt * 32 + 8 * g) = o; }
    }
}

__device__ __forceinline__ void final_norm(const Ptrs& P, int gw, int NGW, int lane) {
    const float* ssq2 = (const float*)(P.ws + WS_SSQ2);
    f32x4 g[4];
#pragma unroll
    for (int j = 0; j < 4; ++j) g[j] = ((const f32x4*)P.fng)[lane + 64 * j];
    for (int m = gw; m < M; m += NGW) { f32x4* xr = (f32x4*)(P.out + (size_t)m * D) + lane;
        const float rs = __builtin_amdgcn_rsqf(ssq2[m] * (1.0f / 1024.0f) + 1e-6f);
#pragma unroll
        for (int j = 0; j < 4; ++j) { const f32x4 v = xr[64 * j]; xr[64 * j] = v * rs * g[j]; } }
}

struct Args { Ptrs p; int ph_lo, ph_hi; };
__global__ void __launch_bounds__(NT, 2) trunk_fwd(Args args) {
    extern __shared__ __attribute__((aligned(16))) unsigned char lds_raw[];
    LAS unsigned char* lds = (LAS unsigned char*)lds_raw;
    cg::grid_group grid = cg::this_grid();
    const Ptrs& P = args.p;
    const int tid = threadIdx.x, lane = tid & 63, wave = __builtin_amdgcn_readfirstlane(tid >> 6);
    const int G = gridDim.x, gw = blockIdx.x * NWAVES + wave, NGW = G * NWAVES, gtid = blockIdx.x * NT + tid, GT = G * NT;
    const int lo = args.ph_lo, hi = args.ph_hi;
#define IN(k) (lo <= (k) && (k) < hi)
#define SEAM(k) do { if (IN(k) && IN((k) + 1)) grid.sync(); } while (0)
    unsigned char* ws = P.ws;
    if (IN(0)) { p0_prologue(P, lds, gw, NGW, wave, lane, gtid, GT); __syncthreads(); }
    SEAM(0);
#ifndef NO_GEMM
    if (IN(1)) {
        pg8::Gemm g{(const bf16*)(ws + WS_XB), (const bf16*)(ws + WS_W0T), M, NIN0, D}; pg8::StaticOrder S; S.init(M, NIN0, G, (int)blockIdx.x);
        pg8::EpiRowScale E{(bf16*)(ws + WS_U0), NIN0, (const float*)(ws + WS_SSQ0), 0, 1.0f};
        pg8::gemm_phase<pg8::EpiRowScale, pg8::StaticOrder, true, true>(lds, g, S, E);
    }
#endif
    SEAM(1);
#ifndef NO_LRUA
    if (IN(2)) lru_phase<false>(P, lds, G, wave, lane, tid);
#endif
    SEAM(2);
#ifndef NO_LRUB
    if (IN(3)) lru_phase<true>(P, lds, G, wave, lane, tid);
#endif
    SEAM(3);
#ifndef NO_GEMM
    if (IN(4)) {
        pg8::Gemm g{(const bf16*)(ws + WS_YG), (const bf16*)(ws + WS_WO0T), M, D, LW}; pg8::StaticOrder S; S.init(M, D, G, (int)blockIdx.x);
        pg8::EpiResid<true> E{P.x, P.out, (bf16*)(ws + WS_XB), (float*)(ws + WS_SSQ1), D};
        pg8::gemm_phase<pg8::EpiResid<true>, pg8::StaticOrder, false, true>(lds, g, S, E);
    }
    SEAM(4);
    if (IN(5)) {
        { pg8::Gemm g{(const bf16*)(ws + WS_XB), (const bf16*)(ws + WS_W1T), M, NQKG, D}; pg8::StaticOrder S; S.init(M, NQKG, G, (int)blockIdx.x);
          pg8::EpiRowScale E{(bf16*)(ws + WS_U1), NQKG, (const float*)(ws + WS_SSQ1), AW, QSCALE};
          pg8::gemm_phase<pg8::EpiRowScale, pg8::StaticOrder, true, true>(lds, g, S, E); }
        { pg8::Gemm g{(const bf16*)(ws + WS_W1T) + (size_t)NQKG * D, (const bf16*)(ws + WS_XB), AW, M, D}; pg8::StaticOrder S; S.init(AW, M, G, (int)blockIdx.x);
          pg8::EpiColScale E{(bf16*)(ws + WS_VT), M, (const float*)(ws + WS_SSQ1)};
          pg8::gemm_phase<pg8::EpiColScale, pg8::StaticOrder, false, true>(lds, g, S, E); }
    }
#endif
    SEAM(5);
#ifndef NO_ATTN
    if (IN(6)) attn_phase(P, gw, NGW, lane);
#endif
    SEAM(6);
#ifndef NO_GEMM
    if (IN(7)) {
        pg8::Gemm g{(const bf16*)(ws + WS_OG), (const bf16*)(ws + WS_WO1T), M, D, AW}; pg8::StaticOrder S; S.init(M, D, G, (int)blockIdx.x);
        pg8::EpiResid<false> E{P.out, P.out, nullptr, (float*)(ws + WS_SSQ2), D};
        pg8::gemm_phase<pg8::EpiResid<false>, pg8::StaticOrder, false, true>(lds, g, S, E);
    }
#endif
    SEAM(7);
    if (IN(8)) final_norm(P, gw, NGW, lane);
#undef IN
#undef SEAM
}

#ifndef N_LAUNCHES
#define N_LAUNCHES 1
#endif
extern "C" void kernel_launch(void* const* d_in, const int* in_sizes, int n_in, void* d_out, int out_size, void* d_ws, size_t ws_size, hipStream_t stream) {
    static int grid = 0;
    if (grid == 0) {
        if (n_in != 12 || in_sizes[0] != M * D || out_size != M * D || ws_size < WS_END) { fprintf(stderr, "kernel_launch: unexpected shapes (n_in %d, in0 %d, out %d, ws %zu)\n", n_in, n_in > 0 ? in_sizes[0] : -1, out_size, ws_size); grid = -1; return; }
        int dev = 0, cus = 0, per_cu = 0;
        hipGetDevice(&dev); hipDeviceGetAttribute(&cus, hipDeviceAttributeMultiprocessorCount, dev);
        hipFuncSetAttribute((const void*)trunk_fwd, hipFuncAttributeMaxDynamicSharedMemorySize, LDS_BYTES);
        hipOccupancyMaxActiveBlocksPerMultiprocessor(&per_cu, (const void*)trunk_fwd, NT, LDS_BYTES);
        if (per_cu < 1) { fprintf(stderr, "kernel_launch: occupancy query reports %d workgroups per CU\n", per_cu); per_cu = 1; }
        (void)hipGetLastError();
        grid = cus * 1;
        fprintf(stderr, "kernel_launch: grid %d (cus %d, per_cu %d)\n", grid, cus, per_cu);
    }
    if (grid < 0) return;
    Args a{};
    a.p.x = (const float*)d_in[0]; a.p.norm_g = (const float*)d_in[1]; a.p.fng = (const float*)d_in[2]; a.p.lwin = (const float*)d_in[3];
    a.p.lcw = (const float*)d_in[4]; a.p.lcb = (const float*)d_in[5]; a.p.lwg = (const float*)d_in[6]; a.p.lbg = (const float*)d_in[7];
    a.p.llam = (const float*)d_in[8]; a.p.lwout = (const float*)d_in[9]; a.p.swin = (const float*)d_in[10]; a.p.swout = (const float*)d_in[11];
    a.p.out = (float*)d_out; a.p.ws = (unsigned char*)d_ws;
#if N_LAUNCHES == 1
    a.ph_lo = 0; a.ph_hi = 9;
    void* kargs[] = {&a};
    hipError_t e = hipLaunchCooperativeKernel((const void*)trunk_fwd, dim3(grid), dim3(NT), kargs, LDS_BYTES, stream);
    if (e != hipSuccess) fprintf(stderr, "cooperative launch failed: %s (grid %d)\n", hipGetErrorString(e), grid);
#else
    for (int ph = 0; ph < 9; ++ph) { a.ph_lo = ph; a.ph_hi = ph + 1; hipLaunchKernelGGL(trunk_fwd, dim3(grid), dim3(NT), LDS_BYTES, stream, a); }
#endif
}
```

```cpp
#include <hip/hip_runtime.h>
#include <hip/hip_cooperative_groups.h>
#include <cstdio>
#include <cstdint>
namespace cg = cooperative_groups;
namespace pg8 {
#define PG8_LAS __attribute__((address_space(3)))
typedef unsigned short bf16_t;
typedef short bf16x8 __attribute__((ext_vector_type(8)));
typedef float f32x4 __attribute__((ext_vector_type(4)));
typedef unsigned u32x4 __attribute__((ext_vector_type(4)));
constexpr int BM = 256, BK = 64, HALF = 128, HTB = HALF * BK * 2  , STAGE_BYTES = 8 * HTB, NXCD = 8, WGM = 8;

__host__ __device__ __forceinline__ int lds_byte(int r, int c) { const int st = (r >> 4) * 2 + (c >> 5), rr = r & 15, cc = c & 31, ob = rr * 64 + cc * 2; return st * 1024 + (ob ^ (((ob >> 9) & 1) << 5)); }
__host__ __device__ __forceinline__ void stage_rc(int b, int& R, int& C) { const int st = b / 1024, sb = b % 1024, swz = sb ^ (((sb >> 9) & 1) << 5); R = (st >> 1) * 16 + swz / 64; C = (st & 1) * 32 + (swz % 64) / 2; }
__host__ __device__ __forceinline__ int perm32(int rho) { const int n = rho >> 4, i = rho & 15; return 8 * (i >> 2) + 4 * n + (i & 3); }

struct Unit { int pm, pn; };
struct Gemm { const bf16_t* A; const bf16_t* Bt; int M, N, K; };

struct StaticOrder {
    int nM, nN, nwg, G, c;
    __host__ __device__ void init(int M, int N, int G_, int c_) { nM = M / BM; nN = N / BM; nwg = nM * nN; G = G_; c = c_; }
    __host__ __device__ bool next(int i, Unit& u) const {
        const long L = (long)i * G + c; if (L >= nwg) return false;
        int wgid = (int)L; { const int q = nwg / NXCD, r = nwg % NXCD, xcd = wgid % NXCD, off = wgid / NXCD; wgid = (xcd < r ? xcd * (q + 1) : r * (q + 1) + (xcd - r) * q) + off; }
        const int nig = WGM * nN, gid = wgid / nig, fm = gid * WGM, gsz = (nM - fm) < WGM ? (nM - fm) : WGM;
        u.pm = fm + ((wgid % nig) % gsz); u.pn = (wgid % nig) / gsz; return true;
    }
    __device__ __forceinline__ void a_ready(const Unit&) const {}
    __device__ __forceinline__ void done(const Unit&) const {}
};

__device__ __forceinline__ unsigned cvt_pk_bf16(float lo, float hi) { unsigned r; asm volatile("v_cvt_pk_bf16_f32 %0, %1, %2" : "=v"(r) : "v"(lo), "v"(hi)); return r; }
typedef float f32x2 __attribute__((ext_vector_type(2)));
struct EpiRowScale {
    static constexpr bool PERM = true, AFTER_DRAIN = false;
    bf16_t* O; int ldc; const float* ssq; int qcols; float qscale;
    __device__ __forceinline__ void operator()(const f32x4 (&acc)[2][2][4][2], const Unit& u, int wr, int wc, int fr, int fq) const {
        const int row0 = u.pm * BM + wr * 64 + fr, colt = u.pn * BM;
        const float sc = (colt < qcols) ? qscale : 1.f;
        const int col0 = colt + wc * 32 + 8 * fq;
#pragma unroll
        for (int ai = 0; ai < 2; ++ai)
#pragma unroll
            for (int m = 0; m < 4; ++m) { const int row = row0 + ai * HALF + m * 16;
                const float rs = __builtin_amdgcn_rsqf(ssq[row] * (1.0f / 1024.0f) + 1e-6f) * sc;
                bf16_t* rowp = O + (size_t)row * ldc + col0;
#pragma unroll
                for (int bj = 0; bj < 2; ++bj) { const f32x4 v0 = acc[ai][bj][m][0] * rs, v1 = acc[ai][bj][m][1] * rs;
                    u32x4 w; w.x = cvt_pk_bf16(v0[0], v0[1]); w.y = cvt_pk_bf16(v0[2], v0[3]); w.z = cvt_pk_bf16(v1[0], v1[1]); w.w = cvt_pk_bf16(v1[2], v1[3]);
                    *(u32x4*)(rowp + bj * HALF) = w; } }
    }
};
struct EpiColScale {
    static constexpr bool PERM = true, AFTER_DRAIN = false;
    bf16_t* O; int ldc; const float* ssq;
    __device__ __forceinline__ void operator()(const f32x4 (&acc)[2][2][4][2], const Unit& u, int wr, int wc, int fr, int fq) const {
        const int row0 = u.pm * BM + wr * 64 + fr, col0 = u.pn * BM + wc * 32 + 8 * fq;
        f32x4 cs[2][2];
#pragma unroll
        for (int bj = 0; bj < 2; ++bj)
#pragma unroll
            for (int n = 0; n < 2; ++n) { const f32x4 q = *(const f32x4*)(ssq + col0 + bj * HALF + 4 * n);
#pragma unroll
                for (int e = 0; e < 4; ++e) cs[bj][n][e] = __builtin_amdgcn_rsqf(q[e] * (1.0f / 1024.0f) + 1e-6f); }
#pragma unroll
        for (int ai = 0; ai < 2; ++ai)
#pragma unroll
            for (int m = 0; m < 4; ++m) { bf16_t* rowp = O + (size_t)(row0 + ai * HALF + m * 16) * ldc + col0;
#pragma unroll
                for (int bj = 0; bj < 2; ++bj) { const f32x4 v0 = acc[ai][bj][m][0] * cs[bj][0], v1 = acc[ai][bj][m][1] * cs[bj][1];
                    u32x4 w; w.x = cvt_pk_bf16(v0[0], v0[1]); w.y = cvt_pk_bf16(v0[2], v0[3]); w.z = cvt_pk_bf16(v1[0], v1[1]); w.w = cvt_pk_bf16(v1[2], v1[3]);
                    *(u32x4*)(rowp + bj * HALF) = w; } }
    }
};
template <bool WB> struct EpiResid {
    static constexpr bool PERM = false, AFTER_DRAIN = false;
    const float* base; float* out; bf16_t* outb; float* ssq; int ldc;
    __device__ __forceinline__ void operator()(const f32x4 (&acc)[2][2][4][2], const Unit& u, int wr, int wc, int fr, int fq) const {
        const int row0 = u.pm * BM + wr * 64 + fr, col0 = u.pn * BM + wc * 32 + 4 * fq;
#pragma unroll
        for (int ai = 0; ai < 2; ++ai)
#pragma unroll
            for (int m = 0; m < 4; ++m) { const int row = row0 + ai * HALF + m * 16; const size_t off = (size_t)row * ldc + col0; float s = 0.f;
#pragma unroll
                for (int bj = 0; bj < 2; ++bj)
#pragma unroll
                    for (int n = 0; n < 2; ++n) { const f32x4 bs = *(const f32x4*)(base + off + bj * HALF + n * 16); const f32x4 v = bs + acc[ai][bj][m][n];
                        *(f32x4*)(out + off + bj * HALF + n * 16) = v; s += (v[0] * v[0] + v[1] * v[1]) + (v[2] * v[2] + v[3] * v[3]);
                        if (WB) { unsigned lo = cvt_pk_bf16(v[0], v[1]), hi = cvt_pk_bf16(v[2], v[3]); *(unsigned long long*)(outb + off + bj * HALF + n * 16) = (unsigned long long)lo | ((unsigned long long)hi << 32); } }
                s += __shfl_xor(s, 16); s += __shfl_xor(s, 32);
                if (fq == 0) atomicAdd(ssq + row, s);
                asm volatile("" ::: "memory"); }
    }
};
template <class Epi, class Sched, bool ALIGN_EPI = false, bool SP2 = false>
__device__ __forceinline__ void gemm_phase(PG8_LAS unsigned char* lds, const Gemm g, const Sched& S, const Epi& E) {
    const int tid = threadIdx.x, wid = __builtin_amdgcn_readfirstlane(tid >> 6), lane = tid & 63, wr = wid >> 2, wc = wid & 3, fr = lane & 15, fq = lane >> 4;
    const int K = g.K, nt = K / BK;
    unsigned voffA[2], voffB[2];
#pragma unroll
    for (int i = 0; i < 2; ++i) { int R, C; stage_rc(tid * 16 + i * 8192, R, C); const int Rb = Epi::PERM ? ((R & ~31) + perm32(R & 31)) : R;
        voffA[i] = (unsigned)(R * K + C) * 2u; voffB[i] = (unsigned)(Rb * K + C) * 2u; }
    const size_t kstep = (size_t)(BK * 2);
    const size_t hstep = (size_t)HALF * K * 2;
    const size_t tstep = 2 * hstep;
    const unsigned ldsw = (unsigned)wid * 1024u;
    const int aoff = lds_byte(wr * 64 + fr, fq * 8), boff = lds_byte(wc * 32 + fr, fq * 8);
#define PG8_SA(b, h) (((b) * 2 + (h)) * HTB)
#define PG8_SB(b, h) ((4 + (b) * 2 + (h)) * HTB)
#define PG8_STAGE(bufoff, gbase, voff) do { _Pragma("unroll") for (int _i = 0; _i < 2; ++_i) \
        __builtin_amdgcn_global_load_lds((const unsigned*)((const char*)(gbase) + (voff)[_i]), (PG8_LAS unsigned*)(lds + (bufoff) + ldsw + _i * 8192), 16, 0, 0); } while (0)
#define PG8_LDA(dst, b, h) do { _Pragma("unroll") for (int m = 0; m < 4; ++m) _Pragma("unroll") for (int k = 0; k < 2; ++k) dst[m][k] = *(const PG8_LAS bf16x8*)(lds + PG8_SA(b, h) + aoff + m * 2048 + k * 1024); } while (0)
#define PG8_LDB(dst, b, h) do { _Pragma("unroll") for (int n = 0; n < 2; ++n) _Pragma("unroll") for (int k = 0; k < 2; ++k) dst[n][k] = *(const PG8_LAS bf16x8*)(lds + PG8_SB(b, h) + boff + n * 2048 + k * 1024); } while (0)
#define PG8_MMA(ai, bj, At, Bt) do { __builtin_amdgcn_s_setprio(1); _Pragma("unroll") for (int m = 0; m < 4; ++m) _Pragma("unroll") for (int n = 0; n < 2; ++n) _Pragma("unroll") for (int k = 0; k < 2; ++k) \
        acc[ai][bj][m][n] = __builtin_amdgcn_mfma_f32_16x16x32_bf16(Bt[n][k], At[m][k], acc[ai][bj][m][n], 0, 0, 0); __builtin_amdgcn_s_setprio(0); } while (0)
#define PG8_WAIT_V(n) asm volatile("s_waitcnt vmcnt(" #n ")" ::: "memory")
#define PG8_WAIT_L(n) asm volatile("s_waitcnt lgkmcnt(" #n ")" ::: "memory")
#define PG8_BAR __builtin_amdgcn_s_barrier()
#define PG8_SCHED __builtin_amdgcn_sched_barrier(0)
    Unit cur, nxt; int ui = 0;
    if (!S.next(0, cur)) return;
    f32x4 acc[2][2][4][2];
#pragma unroll
    for (int a = 0; a < 2; ++a)
#pragma unroll
        for (int b = 0; b < 2; ++b)
#pragma unroll
            for (int m = 0; m < 4; ++m)
#pragma unroll
                for (int n = 0; n < 2; ++n) acc[a][b][m][n] = (f32x4){0.f, 0.f, 0.f, 0.f};
    bf16x8 At[4][2], B0[2][2], B1[2][2];
    const char* cA = (const char*)g.A + (size_t)cur.pm * tstep; const char* cB = (const char*)g.Bt + (size_t)cur.pn * tstep;
    S.a_ready(cur);
    if constexpr (SP2) {
        PG8_STAGE(PG8_SB(0, 0), cB, voffB); PG8_STAGE(PG8_SB(0, 1), cB + hstep, voffB); PG8_STAGE(PG8_SA(0, 0), cA, voffA); PG8_STAGE(PG8_SA(0, 1), cA + hstep, voffA);
        if (wr == 1) PG8_BAR;
        PG8_WAIT_V(2); PG8_BAR;
        PG8_STAGE(PG8_SB(1, 0), cB + kstep, voffB); PG8_STAGE(PG8_SA(1, 0), cA + kstep, voffA); PG8_STAGE(PG8_SB(1, 1), cB + hstep + kstep, voffB);
        PG8_WAIT_V(6); PG8_BAR;
    } else {
        PG8_STAGE(PG8_SB(0, 0), cB, voffB); PG8_STAGE(PG8_SA(0, 0), cA, voffA); PG8_STAGE(PG8_SB(0, 1), cB + hstep, voffB); PG8_STAGE(PG8_SA(0, 1), cA + hstep, voffA);
        if (wr == 1) PG8_BAR;
        PG8_WAIT_V(4); PG8_BAR;
        PG8_STAGE(PG8_SB(1, 0), cB + kstep, voffB); PG8_STAGE(PG8_SA(1, 0), cA + kstep, voffA); PG8_STAGE(PG8_SB(1, 1), cB + hstep + kstep, voffB);
        PG8_WAIT_V(6); PG8_BAR;
    }
    for (;;) {
        const bool has_next = S.next(ui + 1, nxt);
        const char* nA = has_next ? (const char*)g.A + (size_t)nxt.pm * tstep : cA; const char* nB = has_next ? (const char*)g.Bt + (size_t)nxt.pn * tstep : cB;
        for (int t = 0; t < nt; t += 2) {
            const bool last = (t == nt - 2);
            const char* a1 = cA + (size_t)(t + 1) * kstep;
            const char* a2 = last ? nA : cA + (size_t)(t + 2) * kstep; const char* b2 = last ? nB : cB + (size_t)(t + 2) * kstep;
            const char* a3 = a2 + kstep; const char* b3 = b2 + kstep;
            if (last && has_next) S.a_ready(nxt);
            if constexpr (SP2) {
            PG8_LDB(B0, 0, 0); PG8_LDB(B1, 0, 1); PG8_SCHED; PG8_LDA(At, 0, 0); PG8_STAGE(PG8_SA(1, 1), a1 + hstep, voffA);
            PG8_WAIT_V(8); PG8_WAIT_L(0); PG8_BAR; PG8_MMA(0, 0, At, B0); PG8_MMA(0, 1, At, B1); PG8_BAR; PG8_SCHED;
            PG8_LDA(At, 0, 1); PG8_STAGE(PG8_SB(0, 0), b2, voffB); PG8_STAGE(PG8_SB(0, 1), b2 + hstep, voffB); PG8_STAGE(PG8_SA(0, 0), a2, voffA);
            PG8_WAIT_V(8); PG8_WAIT_L(0); PG8_BAR; PG8_MMA(1, 0, At, B0); PG8_MMA(1, 1, At, B1); PG8_BAR; PG8_SCHED;
            PG8_LDB(B0, 1, 0); PG8_LDB(B1, 1, 1); PG8_SCHED; PG8_LDA(At, 1, 0); PG8_STAGE(PG8_SA(0, 1), a2 + hstep, voffA);
            PG8_WAIT_V(8); PG8_WAIT_L(0); PG8_BAR; PG8_MMA(0, 0, At, B0); PG8_MMA(0, 1, At, B1); PG8_BAR; PG8_SCHED;
            PG8_LDA(At, 1, 1); PG8_STAGE(PG8_SB(1, 0), b3, voffB); PG8_STAGE(PG8_SB(1, 1), b3 + hstep, voffB); PG8_STAGE(PG8_SA(1, 0), a3, voffA);
            PG8_WAIT_V(8); PG8_WAIT_L(0); PG8_BAR; PG8_MMA(1, 0, At, B0); PG8_MMA(1, 1, At, B1); PG8_BAR; PG8_SCHED;
            } else {
            PG8_LDB(B0, 0, 0); PG8_SCHED; PG8_LDA(At, 0, 0); PG8_STAGE(PG8_SA(1, 1), a1 + hstep, voffA);
            PG8_WAIT_L(8); PG8_BAR; PG8_WAIT_L(0); PG8_MMA(0, 0, At, B0); PG8_BAR; PG8_SCHED;
            PG8_LDB(B1, 0, 1); PG8_STAGE(PG8_SB(0, 0), b2, voffB);
            PG8_BAR; PG8_WAIT_L(0); PG8_MMA(0, 1, At, B1); PG8_BAR;
            PG8_LDA(At, 0, 1); PG8_STAGE(PG8_SA(0, 0), a2, voffA);
            PG8_BAR; PG8_WAIT_L(0); PG8_MMA(1, 0, At, B0); PG8_BAR; PG8_SCHED;
            PG8_STAGE(PG8_SB(0, 1), b2 + hstep, voffB);
            PG8_WAIT_V(6); PG8_BAR; PG8_MMA(1, 1, At, B1); PG8_BAR;
            PG8_LDB(B0, 1, 0); PG8_SCHED; PG8_LDA(At, 1, 0); PG8_STAGE(PG8_SA(0, 1), a2 + hstep, voffA);
            PG8_WAIT_L(8); PG8_BAR; PG8_WAIT_L(0); PG8_MMA(0, 0, At, B0); PG8_BAR; PG8_SCHED;
            PG8_LDB(B1, 1, 1); PG8_STAGE(PG8_SB(1, 0), b3, voffB);
            PG8_BAR; PG8_WAIT_L(0); PG8_MMA(0, 1, At, B1); PG8_BAR;
            PG8_LDA(At, 1, 1); PG8_STAGE(PG8_SA(1, 0), a3, voffA);
            PG8_BAR; PG8_WAIT_L(0); PG8_MMA(1, 0, At, B0); PG8_BAR; PG8_SCHED;
            PG8_STAGE(PG8_SB(1, 1), b3 + hstep, voffB);
            PG8_WAIT_V(6); PG8_BAR; PG8_MMA(1, 1, At, B1); PG8_BAR;
            }
        }
        if constexpr (ALIGN_EPI) { if (wr == 0) PG8_BAR; }
        if constexpr (!Epi::AFTER_DRAIN) { E(acc, cur, wr, wc, fr, fq); S.done(cur); }
        if (!has_next) break;
#pragma unroll
        for (int a = 0; a < 2; ++a)
#pragma unroll
            for (int b = 0; b < 2; ++b)
#pragma unroll
                for (int m = 0; m < 4; ++m)
#pragma unroll
                    for (int n = 0; n < 2; ++n) acc[a][b][m][n] = (f32x4){0.f, 0.f, 0.f, 0.f};
        cur = nxt; cA = nA; cB = nB; ++ui;
        if constexpr (ALIGN_EPI) { if (wr == 1) PG8_BAR; }
    }
    PG8_WAIT_V(0);
    if constexpr (!ALIGN_EPI) { if (wr == 0) PG8_BAR; }
    PG8_BAR;
    if constexpr (Epi::AFTER_DRAIN) { E.fused(acc, cur, wr, wc, fr, fq, lds, wid, lane); S.done(cur); }
#undef PG8_SA
#undef PG8_SB
#undef PG8_STAGE
#undef PG8_LDA
#undef PG8_LDB
#undef PG8_MMA
#undef PG8_WAIT_V
#undef PG8_WAIT_L
#undef PG8_BAR
#undef PG8_SCHED
}
}
#define LAS __attribute__((address_space(3)))
typedef unsigned short bf16;
typedef unsigned v4u __attribute__((ext_vector_type(4)));
typedef unsigned v2u __attribute__((ext_vector_type(2)));
typedef float f32x4 __attribute__((ext_vector_type(4)));
typedef float f32x16 __attribute__((ext_vector_type(16)));
typedef short bf16x8 __attribute__((ext_vector_type(8)));
typedef float f32x2_t __attribute__((ext_vector_type(2))); typedef __bf16 bf16x2_t __attribute__((ext_vector_type(2)));
constexpr int NWAVES = 8, NT = 512;
constexpr int BATCH = 4, SEQ = 4096, D = 1024, M = BATCH * SEQ;
constexpr int LH = 16, LB = 80, LW = 1280;
constexpr int NIN0 = 2 * LW;
constexpr int AH = 16, HD = 64, AW = 1024, NIN1 = 4 * AW;
constexpr int NQKG = 3 * AW;
constexpr int CHUNK = 256, NCHUNK = SEQ / CHUNK;
constexpr float LOG2E = 1.4426950408889634f, LN2 = 0.6931471805599453f;
constexpr float QSCALE = 0.125f * LOG2E;
constexpr size_t MiB = 1u << 20;
constexpr size_t WS_SSQ0 = 1 * MiB, WS_SSQ1 = WS_SSQ0 + 65536, WS_SSQ2 = WS_SSQ1 + 65536, WS_SUM = WS_SSQ2 + 65536;
constexpr size_t WS_PAR = WS_SUM + 655360;
constexpr size_t WS_W0T = 2 * MiB, WS_WO0T = 8 * MiB, WS_W1T = 11 * MiB, WS_WO1T = 20 * MiB, WS_WGF = 22 * MiB;
constexpr size_t WS_XB = 24 * MiB;
constexpr size_t WS_U0 = 56 * MiB;
constexpr size_t WS_YG = 140 * MiB;
constexpr size_t WS_U1 = 56 * MiB;
constexpr size_t WS_VT = 156 * MiB;
constexpr size_t WS_OG = 188 * MiB;
constexpr size_t WS_END = 220 * MiB;
static_assert(WS_PAR + 40960 <= WS_W0T && WS_U0 + (size_t)M * NIN0 * 2 <= WS_YG && WS_YG + (size_t)M * LW * 2 <= WS_OG && WS_U1 + (size_t)M * NQKG * 2 <= WS_VT && WS_VT + (size_t)M * AW * 2 <= WS_OG, "ws map");
constexpr int LDS_BYTES = 135168;

__device__ __forceinline__ unsigned pk2(float lo, float hi) { f32x2_t v = {lo, hi}; bf16x2_t b = __builtin_convertvector(v, bf16x2_t); return __builtin_bit_cast(unsigned, b); }
__device__ __forceinline__ float bflo(unsigned u) { return __uint_as_float(u << 16); }
__device__ __forceinline__ float bfhi(unsigned u) { return __uint_as_float(u & 0xffff0000u); }
__device__ __forceinline__ float ex2(float x) { return __builtin_amdgcn_exp2f(x); }
__device__ __forceinline__ float rcpf_(float x) { return __builtin_amdgcn_rcpf(x); }
__device__ __forceinline__ float sigmoid_(float x) { return rcpf_(1.0f + ex2(-LOG2E * x)); }
__device__ __forceinline__ float wave_sum(float v) {
#pragma unroll
    for (int o = 1; o < 64; o <<= 1) v += __shfl_xor(v, o);
    return v;
}
#define LDS_WAIT() asm volatile("s_waitcnt lgkmcnt(0)" ::: "memory")
#define MFMA32(a, b, c) __builtin_amdgcn_mfma_f32_32x32x16_bf16((a), (b), (c), 0, 0, 0)
__device__ __forceinline__ int crow(int reg, int h) { return (reg & 3) + 8 * (reg >> 2) + 4 * h; }

__device__ __forceinline__ void p0_transpose_item(const float* W, int K, int N, bf16* WT, const float* ks, int radd, LAS float* scr, int kb, int nb, int lane) {
    const int k0 = 64 * kb, n0 = 32 * nb;
#pragma unroll 8
    for (int i = 0; i < 32; ++i) { const int kk = 2 * i + (lane >> 5); const float s = ks ? ks[k0 + kk] : 1.0f; scr[kk * 33 + (lane & 31)] = W[(size_t)(k0 + kk) * N + n0 + (lane & 31)] * s; }
    LDS_WAIT(); asm volatile("" ::: "memory");
    const int c = lane & 7;
#pragma unroll
    for (int j = 0; j < 4; ++j) { const int n = (lane >> 3) + 8 * j; const LAS float* s = scr + (8 * c) * 33 + n;
        v4u o; o.x = pk2(s[0 * 33], s[1 * 33]); o.y = pk2(s[2 * 33], s[3 * 33]); o.z = pk2(s[4 * 33], s[5 * 33]); o.w = pk2(s[6 * 33], s[7 * 33]);
        *(v4u*)(WT + (size_t)(radd + n0 + n) * K + k0 + 8 * c) = o; }
    LDS_WAIT(); asm volatile("" ::: "memory");
}
struct Ptrs {
    const float *x, *norm_g, *fng, *lwin, *lcw, *lcb, *lwg, *lbg, *llam, *lwout, *swin, *swout;
    float* out; unsigned char* ws;
};
__device__ __forceinline__ void p0_prologue(const Ptrs& P, LAS unsigned char* lds, int gw, int NGW, int wave, int lane, int gtid, int GT) {
    LAS float* scr = (LAS float*)(lds + wave * 16384);
    bf16* W0T = (bf16*)(P.ws + WS_W0T); bf16* WO0T = (bf16*)(P.ws + WS_WO0T); bf16* W1T = (bf16*)(P.ws + WS_W1T); bf16* WO1T = (bf16*)(P.ws + WS_WO1T);
    constexpr int I0 = (D / 64) * (NIN0 / 32), I1 = (LW / 64) * (D / 32), I2 = (D / 64) * (NIN1 / 32), I3 = (AW / 64) * (D / 32);
    for (int it = gw; it < I0 + I1 + I2 + I3; it += NGW) {
        int r = it;
        if (r < I0) { const int nblk = NIN0 / 32; p0_transpose_item(P.lwin, D, NIN0, W0T, P.norm_g, 0, scr, r / nblk, r % nblk, lane); continue; } r -= I0;
        if (r < I1) { const int nblk = D / 32; p0_transpose_item(P.lwout, LW, D, WO0T, nullptr, 0, scr, r / nblk, r % nblk, lane); continue; } r -= I1;
        if (r < I2) { const int nblk = NIN1 / 32, nb = r % nblk, n0 = 32 * nb;
            const int radd = (n0 < 2 * AW) ? 0 : (n0 < 3 * AW ? AW : -AW);
            p0_transpose_item(P.swin, D, NIN1, W1T, P.norm_g + D, radd, scr, r / nblk, nb, lane); continue; } r -= I2;
        { const int nblk = D / 32; p0_transpose_item(P.swout, AW, D, WO1T, nullptr, 0, scr, r / nblk, r % nblk, lane); }
    }
    bf16* WGF = (bf16*)(P.ws + WS_WGF);
    for (int g = gtid; g < LH * 6 * 5 * 64; g += GT) {
        const int l = g & 63, s = (g >> 6) % 5, tile = (g / 320) % 6, hd = g / 1920, r = l & 31, hh = l >> 5;
        const int cc = 32 * (tile % 3) + r; float v[8];
#pragma unroll
        for (int j = 0; j < 8; ++j) { const int ch = 16 * s + 8 * (j >> 2) + 4 * hh + (j & 3);
            v[j] = (cc < LB) ? P.lwg[((size_t)hd * LB + ch) * (2 * LB) + (tile < 3 ? cc : LB + cc)] : 0.0f; }
        v4u o; o.x = pk2(v[0], v[1]); o.y = pk2(v[2], v[3]); o.z = pk2(v[4], v[5]); o.w = pk2(v[6], v[7]);
        *(v4u*)(WGF + (size_t)g * 8) = o;
    }
    float* PAR = (float*)(P.ws + WS_PAR);
    for (int g = gtid; g < LH * 8 * LB; g += GT) {
        const int ch = g % LB, row = (g / LB) % 8, hd = g / (8 * LB), c = hd * LB + ch; float v;
        if (row < 4) v = P.lcw[row * LW + c];
        else if (row == 4) v = P.lcb[c];
        else if (row == 5) v = P.lbg[hd * 2 * LB + ch];
        else if (row == 6) v = P.lbg[hd * 2 * LB + LB + ch];
        else { const float lam = P.llam[c]; v = 8.0f * LOG2E * (fminf(lam, 0.0f) - log1pf(expf(-fabsf(lam)))); }
        PAR[g] = v;
    }
    float* ssq0 = (float*)(P.ws + WS_SSQ0); float* ssq1 = (float*)(P.ws + WS_SSQ1); float* ssq2 = (float*)(P.ws + WS_SSQ2);
    for (int g = gtid; g < M; g += GT) { ssq1[g] = 0.0f; ssq2[g] = 0.0f; }
    bf16* XB = (bf16*)(P.ws + WS_XB);
    for (int m = gw; m < M; m += NGW) {
        const f32x4* xr = (const f32x4*)(P.x + (size_t)m * D) + lane; unsigned long long* o8 = (unsigned long long*)(XB + (size_t)m * D) + lane;
        f32x4 v[4]; float s = 0.f;
#pragma unroll
        for (int j = 0; j < 4; ++j) { v[j] = xr[64 * j]; s += (v[j].x * v[j].x + v[j].y * v[j].y) + (v[j].z * v[j].z + v[j].w * v[j].w); }
#pragma unroll
        for (int j = 0; j < 4; ++j) o8[64 * j] = (unsigned long long)pk2(v[j].x, v[j].y) | ((unsigned long long)pk2(v[j].z, v[j].w) << 32);
        s = wave_sum(s); if (lane == 0) ssq0[m] = s;
    }
}

template <int CTRL, int RMASK> __device__ __forceinline__ float dpp_f(float old, float src) {
    return __builtin_bit_cast(float, __builtin_amdgcn_update_dpp(__builtin_bit_cast(int, old), __builtin_bit_cast(int, src), CTRL, RMASK, 0xf, false));
}
constexpr int L_WGF = 0, L_PAR = 30720, L_COMP = 33280, L_HIN = 38400, L_SUM = 40960;
template <bool PASSB> __device__ __forceinline__ void lru_phase(const Ptrs& P, LAS unsigned char* lds, int G, int wave, int lane, int tid) {
    const bf16* U0 = (const bf16*)(P.ws + WS_U0); bf16* YG = (bf16*)(P.ws + WS_YG);
    const bf16* WGF = (const bf16*)(P.ws + WS_WGF); const float* PAR = (const float*)(P.ws + WS_PAR); float* SUM = (float*)(P.ws + WS_SUM);
    const int r = lane & 31, hh = lane >> 5;
    for (int u = blockIdx.x; u < 64 * NCHUNK; u += G) {
        const int bh = u & 63, c = u >> 6, b = bh >> 4, hd = bh & 15;
        { const v4u* src = (const v4u*)(WGF + (size_t)hd * 15360); LAS v4u* dst = (LAS v4u*)(lds + L_WGF);
          for (int i = tid; i < 1920; i += NT) dst[i] = src[i];
          const f32x4* ps = (const f32x4*)(PAR + hd * 640); LAS f32x4* pd = (LAS f32x4*)(lds + L_PAR);
          if (tid < 160) pd[tid] = ps[tid];
          if (PASSB) { const f32x4* ss = (const f32x4*)(SUM + (size_t)bh * NCHUNK * 160); LAS f32x4* sd = (LAS f32x4*)(lds + L_SUM);
              for (int i = tid; i < c * 40; i += NT) sd[i] = ss[i]; } }
        __syncthreads();
        const LAS float* par = (const LAS float*)(lds + L_PAR);
        const int tloc = c * CHUNK + wave * 32 + r; const size_t trow = (size_t)b * SEQ + tloc;
        float xc[5][2][4]; bf16x8 xf[5];
        { const bf16* up = U0 + trow * NIN0 + hd * LB + 4 * hh;
#pragma unroll
          for (int s = 0; s < 5; ++s) { unsigned pkd[4];
#pragma unroll
              for (int half = 0; half < 2; ++half) { const int ch0 = 16 * s + 8 * half;
                  const f32x4 cb = *(const LAS f32x4*)(par + 4 * LB + ch0 + 4 * hh);
                  float a0 = cb[0], a1 = cb[1], a2 = cb[2], a3 = cb[3];
#pragma unroll
                  for (int tap = 0; tap < 4; ++tap) { const bool ok = (tloc - 3 + tap) >= 0;
                      v2u raw = *(const v2u*)(up + (ok ? (ptrdiff_t)(tap - 3) * NIN0 : (ptrdiff_t)0) + ch0); raw.x = ok ? raw.x : 0u; raw.y = ok ? raw.y : 0u;
                      const f32x4 cw = *(const LAS f32x4*)(par + tap * LB + ch0 + 4 * hh);
                      a0 += cw[0] * bflo(raw.x); a1 += cw[1] * bfhi(raw.x); a2 += cw[2] * bflo(raw.y); a3 += cw[3] * bfhi(raw.y); }
                  asm volatile("" : "+v"(a0), "+v"(a1), "+v"(a2), "+v"(a3));
                  xc[s][half][0] = a0; xc[s][half][1] = a1; xc[s][half][2] = a2; xc[s][half][3] = a3;
                  pkd[2 * half] = pk2(a0, a1); pkd[2 * half + 1] = pk2(a2, a3); __builtin_amdgcn_sched_barrier(0); }
              v4u t = {pkd[0], pkd[1], pkd[2], pkd[3]}; xf[s] = __builtin_bit_cast(bf16x8, t); __builtin_amdgcn_sched_barrier(0); } }
        float Av[5][2][4];
#pragma unroll
        for (int mt = 0; mt < 3; ++mt) {
            f32x16 gr, gi;
#pragma unroll
            for (int i = 0; i < 16; ++i) { gr[i] = 0.f; gi[i] = 0.f; }
            const LAS bf16x8* wa = (const LAS bf16x8*)(lds + L_WGF) + (size_t)(mt * 5) * 64 + lane;
            const LAS bf16x8* wb = (const LAS bf16x8*)(lds + L_WGF) + (size_t)((3 + mt) * 5) * 64 + lane;
#pragma unroll
            for (int s = 0; s < 5; ++s) { gr = MFMA32(wa[s * 64], xf[s], gr); gi = MFMA32(wb[s * 64], xf[s], gi); }
            __builtin_amdgcn_sched_barrier(0);
#pragma unroll
            for (int i4 = 0; i4 < 4; ++i4) { if (mt == 2 && i4 >= 2) continue;
                const int s = 2 * mt + (i4 >> 1), half = i4 & 1, ch0 = 16 * s + 8 * half + 4 * hh;
                const f32x4 bgr = *(const LAS f32x4*)(par + 5 * LB + ch0), bgi = *(const LAS f32x4*)(par + 6 * LB + ch0), ls2 = *(const LAS f32x4*)(par + 7 * LB + ch0);
#pragma unroll
                for (int q = 0; q < 4; ++q) { const int i = 4 * i4 + q;
                    const float rg = sigmoid_(gr[i] + bgr[q]), ig = sigmoid_(gi[i] + bgi[q]);
                    const float la2 = ls2[q] * rg, a = ex2(la2), xx = (2.0f * LN2) * la2;
                    const float poly = -xx * (1.0f + xx * (0.5f + xx * ((1.0f / 6.0f) + xx * ((1.0f / 24.0f) + xx * ((1.0f / 120.0f) + xx * (1.0f / 720.0f))))));
                    const float om = (xx > -0.25f) ? poly : (1.0f - a * a);
                    const float bt = __builtin_sqrtf(om) * (ig * xc[s][half][q]);
                    Av[s][half][q] = a; xc[s][half][q] = bt; }
                asm volatile("" : "+v"(Av[s][half][0]), "+v"(Av[s][half][1]), "+v"(Av[s][half][2]), "+v"(Av[s][half][3]), "+v"(xc[s][half][0]), "+v"(xc[s][half][1]), "+v"(xc[s][half][2]), "+v"(xc[s][half][3]));
                __builtin_amdgcn_sched_barrier(0); }
        }
#pragma unroll
        for (int s = 0; s < 5; ++s)
#pragma unroll
            for (int half = 0; half < 2; ++half)
#pragma unroll
                for (int q = 0; q < 4; ++q) { float A = Av[s][half][q], Bv = xc[s][half][q];
#define LRU_STEP(CTRL, RMASK) { const float ap = dpp_f<CTRL, RMASK>(1.0f, A), bp = dpp_f<CTRL, RMASK>(0.0f, Bv); Bv = A * bp + Bv; A = A * ap; }
                    LRU_STEP(0x111, 0xf) LRU_STEP(0x112, 0xf) LRU_STEP(0x114, 0xf) LRU_STEP(0x118, 0xf) LRU_STEP(0x142, 0xa)
#undef LRU_STEP
                    asm volatile("" : "+v"(A), "+v"(Bv));
                    Av[s][half][q] = A; xc[s][half][q] = Bv; if (q == 3) __builtin_amdgcn_sched_barrier(0); }
        if (r == 31) { LAS float* cp = (LAS float*)(lds + L_COMP) + wave * 160 + 4 * hh;
#pragma unroll
            for (int s = 0; s < 5; ++s)
#pragma unroll
                for (int half = 0; half < 2; ++half) { const int ch0 = 16 * s + 8 * half;
                    *(LAS f32x4*)(cp + ch0) = (f32x4){Av[s][half][0], Av[s][half][1], Av[s][half][2], Av[s][half][3]};
                    *(LAS f32x4*)(cp + 80 + ch0) = (f32x4){xc[s][half][0], xc[s][half][1], xc[s][half][2], xc[s][half][3]}; } }
        __syncthreads();
        if (tid < LB) { const LAS float* cp = (const LAS float*)(lds + L_COMP) + tid;
            if (!PASSB) { float Au = 1.0f, Bu = 0.0f;
#pragma unroll
                for (int w = 0; w < 8; ++w) { const float a = cp[w * 160], bb = cp[w * 160 + 80]; Bu = a * Bu + bb; Au = Au * a; }
                float* so = SUM + ((size_t)bh * NCHUNK + c) * 160 + tid; so[0] = Au; so[80] = Bu;
            } else { const LAS float* sp = (const LAS float*)(lds + L_SUM) + tid; float h = 0.0f;
                for (int cc = 0; cc < c; ++cc) h = sp[cc * 160] * h + sp[cc * 160 + 80];
                LAS float* hp = (LAS float*)(lds + L_HIN) + tid;
#pragma unroll
                for (int w = 0; w < 8; ++w) { hp[w * 80] = h; h = cp[w * 160] * h + cp[w * 160 + 80]; } } }
        if (PASSB) {
            __syncthreads();
            const LAS float* hp = (const LAS float*)(lds + L_HIN) + wave * 80 + 4 * hh;
            const bf16* gp = U0 + trow * NIN0 + LW + hd * LB + 4 * hh; bf16* yp = YG + trow * LW + hd * LB + 4 * hh;
#pragma unroll
            for (int s = 0; s < 5; ++s)
#pragma unroll
                for (int half = 0; half < 2; ++half) { const int ch0 = 16 * s + 8 * half;
                    const f32x4 hin = *(const LAS f32x4*)(hp + ch0); const v2u graw = *(const v2u*)(gp + ch0);
                    const float g0 = bflo(graw.x), g1 = bfhi(graw.x), g2 = bflo(graw.y), g3 = bfhi(graw.y);
                    const float y0 = (xc[s][half][0] + Av[s][half][0] * hin[0]) * (g0 * sigmoid_(g0));
                    const float y1 = (xc[s][half][1] + Av[s][half][1] * hin[1]) * (g1 * sigmoid_(g1));
                    const float y2 = (xc[s][half][2] + Av[s][half][2] * hin[2]) * (g2 * sigmoid_(g2));
                    const float y3 = (xc[s][half][3] + Av[s][half][3] * hin[3]) * (g3 * sigmoid_(g3));
                    v2u o; o.x = pk2(y0, y1); o.y = pk2(y2, y3); *(v2u*)(yp + ch0) = o; __builtin_amdgcn_sched_barrier(0); }
        }
        __syncthreads();
    }
}
__device__ __forceinline__ void attn_phase(const Ptrs& P, int gw, int NGW, int lane) {
    const bf16* U1 = (const bf16*)(P.ws + WS_U1); const bf16* VT = (const bf16*)(P.ws + WS_VT); bf16* OG = (bf16*)(P.ws + WS_OG);
    const int r = lane & 31, hh = lane >> 5;
    for (int u = gw; u < BATCH * AH * (SEQ / 32); u += NGW) {
        const int qt = u & 127, bhh = u >> 7, b = bhh >> 4, h = bhh & 15;
        const size_t rowbase = (size_t)b * SEQ;
        bf16x8 qf[4], kf[4];
        { const bf16* qp = U1 + (rowbase + qt * 32 + r) * NQKG + h * HD + 8 * hh;
#pragma unroll
          for (int ks = 0; ks < 4; ++ks) qf[ks] = *(const bf16x8*)(qp + 16 * ks); }
        const bf16* kbase = U1 + rowbase * NQKG + AW + h * HD + 8 * hh;
        const bf16* vbase = VT + (size_t)(h * HD + r) * M + rowbase + 4 * hh;
        { const bf16* kp = kbase + (size_t)(qt * 32 + r) * NQKG;
#pragma unroll
          for (int ks = 0; ks < 4; ++ks) kf[ks] = *(const bf16x8*)(kp + 16 * ks); }
        f32x16 o0, o1;
#pragma unroll
        for (int i = 0; i < 16; ++i) { o0[i] = 0.f; o1[i] = 0.f; }
        float Pc = 1.0f;
        for (int kt = qt; kt >= 0; --kt) {
            v2u vf[2][2][2]; const bf16* vp = vbase + kt * 32;
#pragma unroll
            for (int dt = 0; dt < 2; ++dt)
#pragma unroll
                for (int s = 0; s < 2; ++s)
#pragma unroll
                    for (int half = 0; half < 2; ++half) vf[dt][s][half] = *(const v2u*)(vp + (size_t)dt * 32 * M + 16 * s + 8 * half);
            bf16x8 kn[4];
            { const int ktn = kt > 0 ? kt - 1 : 0; const bf16* kp = kbase + (size_t)(ktn * 32 + r) * NQKG;
#pragma unroll
              for (int ks = 0; ks < 4; ++ks) kn[ks] = *(const bf16x8*)(kp + 16 * ks); }
            f32x16 sa;
#pragma unroll
            for (int i = 0; i < 16; ++i) sa[i] = 0.f;
#pragma unroll
            for (int ks = 0; ks < 4; ++ks) sa = MFMA32(kf[ks], qf[ks], sa);
            float beta[16], f[16];
            const bool diag = (kt == qt);
#pragma unroll
            for (int i = 0; i < 16; ++i) { const float z = sa[i], e = ex2(-__builtin_fabsf(z)), rr = rcpf_(1.0f + e), er = e * rr; const bool pos = z >= 0.0f;
                float bt = pos ? rr : er, ff = pos ? er : rr;
                if (diag) { const bool valid = crow(i, hh) < r; bt = valid ? bt : 0.0f; ff = valid ? ff : 1.0f; }
                beta[i] = bt; f[i] = ff; }
            float gp[4], ot[4], pr[4];
#pragma unroll
            for (int g = 0; g < 4; ++g) { gp[g] = (f[4 * g] * f[4 * g + 1]) * (f[4 * g + 2] * f[4 * g + 3]); ot[g] = __shfl_xor(gp[g], 32); pr[g] = gp[g] * ot[g]; }
            float suf = Pc; float att[16];
#pragma unroll
            for (int g = 3; g >= 0; --g) { float p = (hh == 0) ? suf * ot[g] : suf;
                att[4 * g + 3] = beta[4 * g + 3] * p; p *= f[4 * g + 3];
                att[4 * g + 2] = beta[4 * g + 2] * p; p *= f[4 * g + 2];
                att[4 * g + 1] = beta[4 * g + 1] * p; p *= f[4 * g + 1];
                att[4 * g] = beta[4 * g] * p;
                suf *= pr[g]; }
            Pc = suf;
            bf16x8 pf[2];
#pragma unroll
            for (int s = 0; s < 2; ++s) { v4u t; t.x = pk2(att[8 * s], att[8 * s + 1]); t.y = pk2(att[8 * s + 2], att[8 * s + 3]); t.z = pk2(att[8 * s + 4], att[8 * s + 5]); t.w = pk2(att[8 * s + 6], att[8 * s + 7]); pf[s] = __builtin_bit_cast(bf16x8, t); }
#pragma unroll
            for (int s = 0; s < 2; ++s) { v4u a0 = {vf[0][s][0].x, vf[0][s][0].y, vf[0][s][1].x, vf[0][s][1].y}, a1 = {vf[1][s][0].x, vf[1][s][0].y, vf[1][s][1].x, vf[1][s][1].y};
                o0 = MFMA32(__builtin_bit_cast(bf16x8, a0), pf[s], o0); o1 = MFMA32(__builtin_bit_cast(bf16x8, a1), pf[s], o1); }
#pragma unroll
            for (int ks = 0; ks < 4; ++ks) kf[ks] = kn[ks];
            if (__builtin_amdgcn_ballot_w64(Pc != 0.0f) == 0ull) break;
        }
        const size_t row = rowbase + qt * 32 + r;
        const bf16* gp_ = U1 + row * NQKG + 2 * AW + h * HD + 4 * hh; bf16* op = OG + row * AW + h * HD + 4 * hh;
#pragma unroll
        for (int dt = 0; dt < 2; ++dt)
#pragma unroll
            for (int g = 0; g < 4; ++g) { const v2u graw = *(const v2u*)(gp_ + dt * 32 + 8 * g);
                const float g0 = bflo(graw.x), g1 = bfhi(graw.x), g2 = bflo(graw.y), g3 = bfhi(graw.y);
                const float v0 = dt ? o1[4 * g] : o0[4 * g], v1 = dt ? o1[4 * g + 1] : o0[4 * g + 1], v2 = dt ? o1[4 * g + 2] : o0[4 * g + 2], v3 = dt ? o1[4 * g + 3] : o0[4 * g + 3];
                v2u o; o.x = pk2(v0 * (g0 * sigmoid_(g0)), v1 * (g1 * sigmoid_(g1))); o.y = pk2(v2 * (g2 * sigmoid_(g2)), v3 * (g3 * sigmoid_(g3)));
                *(v2u*)(op + dt * 32 + 8 * g) = o; }
    }
}

__device__ __forceinline__ void final_norm(const Ptrs& P, int gw, int NGW, int lane) {
    const float* ssq2 = (const float*)(P.ws + WS_SSQ2);
    f32x4 g[4];
#pragma unroll
    for (int j = 0; j < 4; ++j) g[j] = ((const f32x4*)P.fng)[lane + 64 * j];
    for (int m = gw; m < M; m += NGW) { f32x4* xr = (f32x4*)(P.out + (size_t)m * D) + lane;
        const float rs = __builtin_amdgcn_rsqf(ssq2[m] * (1.0f / 1024.0f) + 1e-6f);
#pragma unroll
        for (int j = 0; j < 4; ++j) { const f32x4 v = xr[64 * j]; xr[64 * j] = v * rs * g[j]; } }
}

#define XB_TMO      128
#define XB_XCNT(j)  (256  + 64 * (j))
#define XB_XSUB(j)  (1280 + 64 * (j))
#define XB_XGEN(j)  (2304 + 64 * (j))
#define XB_TOP      3328
#define XB_TOPGEN   3392
#define XCD_BAR_WORDS 3456
#define XB_SPIN_CAP (1u << 18)

__device__ __forceinline__ unsigned xb_ld(unsigned* p)              { return __hip_atomic_load(p, __ATOMIC_RELAXED, __HIP_MEMORY_SCOPE_AGENT); }
__device__ __forceinline__ unsigned xb_add(unsigned* p, unsigned v) { return __hip_atomic_fetch_add(p, v, __ATOMIC_RELAXED, __HIP_MEMORY_SCOPE_AGENT); }
__device__ __forceinline__ unsigned xb_xcc_id() { return (unsigned)__builtin_amdgcn_s_getreg((3 << 11) | 20) & 0xFu; }
#define XB_SPIN(cond, bar) do { unsigned _sp = 0; while (cond) { __builtin_amdgcn_s_sleep(1); \
    if ((++_sp & 255u) == 0u) { if (xb_ld(&(bar)[XB_TMO])) break; if (_sp > XB_SPIN_CAP) { atomicAdd(&(bar)[XB_TMO], 1u); break; } } } } while (0)

struct XcdBarrier {
    unsigned* bar; unsigned x;
    volatile LAS unsigned* st;
};

__device__ __forceinline__ XcdBarrier xcd_barrier_post(unsigned* bar, volatile LAS unsigned* st) {
    XcdBarrier b; b.bar = bar; b.x = xb_xcc_id(); b.st = st;
    if (threadIdx.x == 0) (void)xb_add(&bar[XB_XCNT(b.x)], 1u);
    return b;
}
__device__ __forceinline__ void xcd_barrier_complete(unsigned* bar, unsigned x, unsigned& nloc, unsigned& nx) {
    const unsigned G = gridDim.x * gridDim.y * gridDim.z;
    unsigned sum, cnt, mine, sp = 0u;
    for (;;) {
        sum = 0u; cnt = 0u; mine = 0u;
#pragma unroll
        for (unsigned j = 0; j < 16; ++j) { const unsigned c = xb_ld(&bar[XB_XCNT(j)]); sum += c; cnt += (c > 0u) ? 1u : 0u; mine = (j == x) ? c : mine; }
        if (sum == G) break;
        __builtin_amdgcn_s_sleep(1);
        if ((++sp & 255u) == 0u) { if (xb_ld(&bar[XB_TMO])) break; if (sp > XB_SPIN_CAP) { atomicAdd(&bar[XB_TMO], 1u); break; } }
    }
    nloc = mine > 0u ? mine : 1u; nx = cnt > 0u ? cnt : 1u;
}

__device__ __forceinline__ void xcd_barrier(const XcdBarrier& b) {
    asm volatile("s_waitcnt vmcnt(0)" ::: "memory");
    __syncthreads();
    if (threadIdx.x == 0) {
        unsigned* bar = b.bar;
        __builtin_amdgcn_s_waitcnt(0);
        unsigned nloc = b.st[0], nx = b.st[1];
        if (nloc == 0u) { xcd_barrier_complete(bar, b.x, nloc, nx); b.st[0] = nloc; b.st[1] = nx; }
        const unsigned old = xb_add(&bar[XB_XSUB(b.x)], 1u);
        const unsigned gen = old / nloc;
        if (old + 1u == (gen + 1u) * nloc) {
            __builtin_amdgcn_fence(__ATOMIC_RELEASE, "agent");
            asm volatile("s_waitcnt vmcnt(0)" ::: "memory");
            const unsigned og = xb_add(&bar[XB_TOP], 1u);
            const unsigned tg = og / nx;
            if (og + 1u == (tg + 1u) * nx) xb_add(&bar[XB_TOPGEN], 1u);
            else XB_SPIN(xb_ld(&bar[XB_TOPGEN]) == tg, bar);
            __builtin_amdgcn_fence(__ATOMIC_ACQUIRE, "agent");
            xb_add(&bar[XB_XGEN(b.x)], 1u);
            asm volatile("s_waitcnt vmcnt(0)" ::: "memory");
        } else {
            XB_SPIN(xb_ld(&bar[XB_XGEN(b.x)]) == gen, bar);
            __builtin_amdgcn_fence(__ATOMIC_ACQUIRE, "agent");
            asm volatile("s_waitcnt vmcnt(0)" ::: "memory");
        }
    }
    __syncthreads();
}

#ifndef REP_LRUA
#define REP_LRUA 1
#endif
#ifndef REP_ATTN
#define REP_ATTN 1
#endif
#ifndef REP_P0
#define REP_P0 1
#endif
#ifndef REP_SYNC
#define REP_SYNC 1
#endif
struct Args { Ptrs p; int ph_lo, ph_hi, cg_seam0, pad; };
__global__ void __launch_bounds__(NT, 2) trunk_fwd(Args args) {
    extern __shared__ __attribute__((aligned(16))) unsigned char lds_raw[];
    LAS unsigned char* lds = (LAS unsigned char*)lds_raw;
    cg::grid_group grid = cg::this_grid();
    const Ptrs& P = args.p;
    const int tid = threadIdx.x, lane = tid & 63, wave = __builtin_amdgcn_readfirstlane(tid >> 6);
    const int G = gridDim.x, gw = blockIdx.x * NWAVES + wave, NGW = G * NWAVES, gtid = blockIdx.x * NT + tid, GT = G * NT;
    const int lo = args.ph_lo, hi = args.ph_hi;
#define IN(k) (lo <= (k) && (k) < hi)
    if (tid < 8) ((volatile LAS unsigned*)(lds + 131072))[tid] = 0u;
    __syncthreads();
    XcdBarrier bar = xcd_barrier_post((unsigned*)P.ws, (volatile LAS unsigned*)(lds + 131072));
#define SEAM(k) do { if (IN(k) && IN((k) + 1)) { if ((k) == 0 && args.cg_seam0) grid.sync(); else xcd_barrier(bar); } } while (0)
    unsigned char* ws = P.ws;
    if (IN(0)) for (int rep = 0; rep < REP_P0; ++rep) { p0_prologue(P, lds, gw, NGW, wave, lane, gtid, GT); __syncthreads(); }
    SEAM(0);
#ifndef NO_GEMM
    if (IN(1)) {
        pg8::Gemm g{(const bf16*)(ws + WS_XB), (const bf16*)(ws + WS_W0T), M, NIN0, D}; pg8::StaticOrder S; S.init(M, NIN0, G, (int)blockIdx.x);
        pg8::EpiRowScale E{(bf16*)(ws + WS_U0), NIN0, (const float*)(ws + WS_SSQ0), 0, 1.0f};
        pg8::gemm_phase<pg8::EpiRowScale, pg8::StaticOrder, true, true>(lds, g, S, E);
    }
#endif
    SEAM(1);
#ifndef NO_LRUA
    if (IN(2)) for (int rep = 0; rep < REP_LRUA; ++rep) lru_phase<false>(P, lds, G, wave, lane, tid);
#endif
    SEAM(2);
#ifndef NO_LRUB
    if (IN(3)) lru_phase<true>(P, lds, G, wave, lane, tid);
#endif
    SEAM(3);
#ifndef NO_GEMM
    if (IN(4)) {
        pg8::Gemm g{(const bf16*)(ws + WS_YG), (const bf16*)(ws + WS_WO0T), M, D, LW}; pg8::StaticOrder S; S.init(M, D, G, (int)blockIdx.x);
        pg8::EpiResid<true> E{P.x, P.out, (bf16*)(ws + WS_XB), (float*)(ws + WS_SSQ1), D};
        pg8::gemm_phase<pg8::EpiResid<true>, pg8::StaticOrder, false, true>(lds, g, S, E);
    }
    SEAM(4);
    if (IN(5)) {
        { pg8::Gemm g{(const bf16*)(ws + WS_XB), (const bf16*)(ws + WS_W1T), M, NQKG, D}; pg8::StaticOrder S; S.init(M, NQKG, G, (int)blockIdx.x);
          pg8::EpiRowScale E{(bf16*)(ws + WS_U1), NQKG, (const float*)(ws + WS_SSQ1), AW, QSCALE};
          pg8::gemm_phase<pg8::EpiRowScale, pg8::StaticOrder, true, true>(lds, g, S, E); }
        { pg8::Gemm g{(const bf16*)(ws + WS_W1T) + (size_t)NQKG * D, (const bf16*)(ws + WS_XB), AW, M, D}; pg8::StaticOrder S; S.init(AW, M, G, (int)blockIdx.x);
          pg8::EpiColScale E{(bf16*)(ws + WS_VT), M, (const float*)(ws + WS_SSQ1)};
          pg8::gemm_phase<pg8::EpiColScale, pg8::StaticOrder, false, true>(lds, g, S, E); }
    }
#endif
    SEAM(5);
#ifndef NO_ATTN
    if (IN(6)) for (int rep = 0; rep < REP_ATTN; ++rep) attn_phase(P, gw, NGW, lane);
#endif
    SEAM(6);
#ifndef NO_GEMM
    if (IN(7)) {
        pg8::Gemm g{(const bf16*)(ws + WS_OG), (const bf16*)(ws + WS_WO1T), M, D, AW}; pg8::StaticOrder S; S.init(M, D, G, (int)blockIdx.x);
        pg8::EpiResid<false> E{P.out, P.out, nullptr, (float*)(ws + WS_SSQ2), D};
        pg8::gemm_phase<pg8::EpiResid<false>, pg8::StaticOrder, false, true>(lds, g, S, E);
    }
#endif
    SEAM(7);
    if (IN(8)) final_norm(P, gw, NGW, lane);
#undef IN
#undef SEAM
}

#ifndef N_LAUNCHES
#define N_LAUNCHES 1
#endif
#ifndef CG_SEAM0
#define CG_SEAM0 1
#endif
extern "C" void kernel_launch(void* const* d_in, const int* in_sizes, int n_in, void* d_out, int out_size, void* d_ws, size_t ws_size, hipStream_t stream) {
    static int grid = 0;
    if (grid == 0) {
        if (n_in != 12 || in_sizes[0] != M * D || out_size != M * D || ws_size < WS_END) { fprintf(stderr, "kernel_launch: unexpected shapes (n_in %d, in0 %d, out %d, ws %zu)\n", n_in, n_in > 0 ? in_sizes[0] : -1, out_size, ws_size); grid = -1; return; }
        int dev = 0, cus = 0, per_cu = 0;
        hipGetDevice(&dev); hipDeviceGetAttribute(&cus, hipDeviceAttributeMultiprocessorCount, dev);
        hipFuncSetAttribute((const void*)trunk_fwd, hipFuncAttributeMaxDynamicSharedMemorySize, LDS_BYTES);
        hipOccupancyMaxActiveBlocksPerMultiprocessor(&per_cu, (const void*)trunk_fwd, NT, LDS_BYTES);
        if (per_cu < 1) { fprintf(stderr, "kernel_launch: occupancy query reports %d workgroups per CU\n", per_cu); per_cu = 1; }
        (void)hipGetLastError();
        grid = cus * 1;
        fprintf(stderr, "kernel_launch: grid %d (cus %d, per_cu %d)\n", grid, cus, per_cu);
    }
    if (grid < 0) return;
    Args a{};
    a.p.x = (const float*)d_in[0]; a.p.norm_g = (const float*)d_in[1]; a.p.fng = (const float*)d_in[2]; a.p.lwin = (const float*)d_in[3];
    a.p.lcw = (const float*)d_in[4]; a.p.lcb = (const float*)d_in[5]; a.p.lwg = (const float*)d_in[6]; a.p.lbg = (const float*)d_in[7];
    a.p.llam = (const float*)d_in[8]; a.p.lwout = (const float*)d_in[9]; a.p.swin = (const float*)d_in[10]; a.p.swout = (const float*)d_in[11];
    a.p.out = (float*)d_out; a.p.ws = (unsigned char*)d_ws;
#if N_LAUNCHES == 1
    a.ph_lo = 0; a.ph_hi = 9; a.cg_seam0 = CG_SEAM0;
    if (hipMemsetAsync(d_ws, 0, 16384, stream) != hipSuccess) { fprintf(stderr, "kernel_launch: memset of the barrier words failed\n"); return; }
    void* kargs[] = {&a};
    hipError_t e = hipLaunchCooperativeKernel((const void*)trunk_fwd, dim3(grid), dim3(NT), kargs, LDS_BYTES, stream);
    if (e != hipSuccess) fprintf(stderr, "cooperative launch failed: %s (grid %d)\n", hipGetErrorString(e), grid);
#else
    for (int ph = 0; ph < 9; ++ph) { a.ph_lo = ph; a.ph_hi = ph + 1; hipLaunchKernelGGL(trunk_fwd, dim3(grid), dim3(NT), LDS_BYTES, stream, a); }
#endif
}
```

```cpp
#include <hip/hip_runtime.h>
#include <hip/hip_cooperative_groups.h>
#include <cstdio>
#include <cstdint>
namespace cg = cooperative_groups;
namespace pg8 {
#define PG8_LAS __attribute__((address_space(3)))
typedef unsigned short bf16_t;
typedef short bf16x8 __attribute__((ext_vector_type(8)));
typedef float f32x4 __attribute__((ext_vector_type(4)));
typedef unsigned u32x4 __attribute__((ext_vector_type(4)));
constexpr int BM = 256, BK = 64, HALF = 128, HTB = HALF * BK * 2  , STAGE_BYTES = 8 * HTB, NXCD = 8, WGM = 8;

__host__ __device__ __forceinline__ int lds_byte(int r, int c) { const int st = (r >> 4) * 2 + (c >> 5), rr = r & 15, cc = c & 31, ob = rr * 64 + cc * 2; return st * 1024 + (ob ^ (((ob >> 9) & 1) << 5)); }
__host__ __device__ __forceinline__ void stage_rc(int b, int& R, int& C) { const int st = b / 1024, sb = b % 1024, swz = sb ^ (((sb >> 9) & 1) << 5); R = (st >> 1) * 16 + swz / 64; C = (st & 1) * 32 + (swz % 64) / 2; }
__host__ __device__ __forceinline__ int perm32(int rho) { const int n = rho >> 4, i = rho & 15; return 8 * (i >> 2) + 4 * n + (i & 3); }

struct Unit { int pm, pn; };
struct Gemm { const bf16_t* A; const bf16_t* Bt; int M, N, K; };

struct StaticOrder {
    int nM, nN, nwg, G, c;
    __host__ __device__ void init(int M, int N, int G_, int c_) { nM = M / BM; nN = N / BM; nwg = nM * nN; G = G_; c = c_; }
    __host__ __device__ bool next(int i, Unit& u) const {
        const long L = (long)i * G + c; if (L >= nwg) return false;
        int wgid = (int)L; { const int q = nwg / NXCD, r = nwg % NXCD, xcd = wgid % NXCD, off = wgid / NXCD; wgid = (xcd < r ? xcd * (q + 1) : r * (q + 1) + (xcd - r) * q) + off; }
        const int nig = WGM * nN, gid = wgid / nig, fm = gid * WGM, gsz = (nM - fm) < WGM ? (nM - fm) : WGM;
        u.pm = fm + ((wgid % nig) % gsz); u.pn = (wgid % nig) / gsz; return true;
    }
    __device__ __forceinline__ void a_ready(const Unit&) const {}
    __device__ __forceinline__ void done(const Unit&) const {}
};

__device__ __forceinline__ unsigned cvt_pk_bf16(float lo, float hi) { unsigned r; asm volatile("v_cvt_pk_bf16_f32 %0, %1, %2" : "=v"(r) : "v"(lo), "v"(hi)); return r; }
typedef float f32x2 __attribute__((ext_vector_type(2)));
struct EpiResidNorm {
    static constexpr bool PERM = false, AFTER_DRAIN = true;
    const bf16_t* base; float* out; const float* gain; unsigned long long* slots; int ldc;
    __device__ __forceinline__ void fused(f32x4 (&acc)[2][2][4][2], const Unit& u, int wr, int wc, int fr, int fq, PG8_LAS unsigned char* lds, int wid, int lane) const {
        PG8_LAS float* Pp = (PG8_LAS float*)lds; PG8_LAS float* S = (PG8_LAS float*)(lds + 4096);
        const int col0 = u.pn * BM + wc * 32 + 4 * fq;
        unsigned long long rb[2][4][2][2];
#pragma unroll
        for (int ai = 0; ai < 2; ++ai)
#pragma unroll
            for (int m = 0; m < 4; ++m)
#pragma unroll
                for (int bj = 0; bj < 2; ++bj)
#pragma unroll
                    for (int n = 0; n < 2; ++n) rb[ai][m][bj][n] = __builtin_nontemporal_load((const unsigned long long*)(base + (size_t)(u.pm * BM + ai * HALF + wr * 64 + m * 16 + fr) * ldc + col0 + bj * HALF + n * 16));
        asm volatile("" ::: "memory");
#pragma unroll
        for (int ai = 0; ai < 2; ++ai)
#pragma unroll
            for (int m = 0; m < 4; ++m) { const int rl = ai * HALF + wr * 64 + m * 16 + fr; float s = 0.f;
#pragma unroll
                for (int bj = 0; bj < 2; ++bj)
#pragma unroll
                    for (int n = 0; n < 2; ++n) { const unsigned long long rw = rb[ai][m][bj][n]; const unsigned lo = (unsigned)rw, hi = (unsigned)(rw >> 32);
                        const f32x4 bs = {__uint_as_float(lo << 16), __uint_as_float(lo & 0xffff0000u), __uint_as_float(hi << 16), __uint_as_float(hi & 0xffff0000u)};
                        const f32x4 v = bs + acc[ai][bj][m][n]; acc[ai][bj][m][n] = v;
                        s += (v[0] * v[0] + v[1] * v[1]) + (v[2] * v[2] + v[3] * v[3]); }
                s += __shfl_xor(s, 16); s += __shfl_xor(s, 32);
                if (fq == 0) Pp[rl * 4 + wc] = s;
                asm volatile("" ::: "memory"); }
        asm volatile("s_waitcnt lgkmcnt(0)" ::: "memory"); __builtin_amdgcn_s_barrier(); asm volatile("" ::: "memory");
        const int tid = wid * 64 + lane;
        if (tid < 256) { const f32x4 p = *(const PG8_LAS f32x4*)(Pp + tid * 4); const float mine = (p[0] + p[1]) + (p[2] + p[3]);
            unsigned long long* sl = slots + (size_t)(u.pm * BM + tid) * 4;
            __hip_atomic_store(sl + u.pn, (1ull << 32) | (unsigned long long)__float_as_uint(mine), __ATOMIC_RELAXED, __HIP_MEMORY_SCOPE_AGENT);
            float tot = 0.f;
#pragma unroll
            for (int t = 0; t < 4; ++t) { float val = mine;
                if (t != u.pn) { unsigned long long v; unsigned sp = 0;
                    for (;;) { v = __hip_atomic_load(sl + t, __ATOMIC_RELAXED, __HIP_MEMORY_SCOPE_AGENT); if ((unsigned)(v >> 32) == 1u || ++sp > (1u << 22)) break; __builtin_amdgcn_s_sleep(1); }
                    val = __uint_as_float((unsigned)v); }
                tot += val; }
            S[tid] = __builtin_amdgcn_rsqf(tot * (1.0f / 1024.0f) + 1e-6f); }
        asm volatile("s_waitcnt lgkmcnt(0)" ::: "memory"); __builtin_amdgcn_s_barrier(); asm volatile("" ::: "memory");
        f32x4 gv[2][2];
#pragma unroll
        for (int bj = 0; bj < 2; ++bj)
#pragma unroll
            for (int n = 0; n < 2; ++n) gv[bj][n] = *(const f32x4*)(gain + col0 + bj * HALF + n * 16);
#pragma unroll
        for (int ai = 0; ai < 2; ++ai)
#pragma unroll
            for (int m = 0; m < 4; ++m) { const int rl = ai * HALF + wr * 64 + m * 16 + fr; const float rs = S[rl]; const size_t off = (size_t)(u.pm * BM + rl) * ldc + col0;
#pragma unroll
                for (int bj = 0; bj < 2; ++bj)
#pragma unroll
                    for (int n = 0; n < 2; ++n) *(f32x4*)(out + off + bj * HALF + n * 16) = acc[ai][bj][m][n] * rs * gv[bj][n];
                asm volatile("" ::: "memory"); }
    }
};
struct EpiLruIn {
    static constexpr bool PERM = true, AFTER_DRAIN = false;
    bf16_t* XF; const float* ssq;
    __device__ __forceinline__ void operator()(const f32x4 (&acc)[2][2][4][2], const Unit& u, int wr, int wc, int fr, int fq) const {
        const int row0 = u.pm * BM + wr * 64 + fr, colt = u.pn * BM, part = colt >= 1280 ? 1 : 0;
        bf16_t* base = XF + (size_t)part * ((size_t)16384 * 1280);
#pragma unroll
        for (int ai = 0; ai < 2; ++ai)
#pragma unroll
            for (int m = 0; m < 4; ++m) { const int row = row0 + ai * HALF + m * 16;
                const float rs = __builtin_amdgcn_rsqf(ssq[row] * (1.0f / 1024.0f) + 1e-6f);
                const int b = row >> 12, tl = row & 4095, tile = tl >> 5, r = tl & 31;
#pragma unroll
                for (int bj = 0; bj < 2; ++bj) { const int cc = colt - part * 1280 + bj * HALF + wc * 32 + 8 * fq, hd = cc / 80, ch8 = cc - hd * 80;
                    const f32x4 v0 = acc[ai][bj][m][0] * rs, v1 = acc[ai][bj][m][1] * rs;
                    bf16_t* p = base + ((size_t)((((b * 128 + tile) * 16 + hd) * 10 + (ch8 >> 3)) * 64 + r) << 2);
                    *(unsigned long long*)p = (unsigned long long)cvt_pk_bf16(v0[0], v0[1]) | ((unsigned long long)cvt_pk_bf16(v0[2], v0[3]) << 32);
                    *(unsigned long long*)(p + 128) = (unsigned long long)cvt_pk_bf16(v1[0], v1[1]) | ((unsigned long long)cvt_pk_bf16(v1[2], v1[3]) << 32); }
                asm volatile("" ::: "memory"); }
    }
};
struct EpiQKG {
    static constexpr bool PERM = true, AFTER_DRAIN = false;
    bf16_t* QF; const float* ssq; float qscale;
    __device__ __forceinline__ void operator()(const f32x4 (&acc)[2][2][4][2], const Unit& u, int wr, int wc, int fr, int fq) const {
        const int row0 = u.pm * BM + wr * 64 + fr, colt = u.pn * BM, region = colt >> 10;
        const float sc = (region == 0) ? qscale : 1.f;
        bf16_t* base = QF + (size_t)region * ((size_t)16384 * 1024);
#pragma unroll
        for (int ai = 0; ai < 2; ++ai)
#pragma unroll
            for (int m = 0; m < 4; ++m) { const int row = row0 + ai * HALF + m * 16;
                const float rs = __builtin_amdgcn_rsqf(ssq[row] * (1.0f / 1024.0f) + 1e-6f) * sc;
                const int b = row >> 12, tl = row & 4095, tile = tl >> 5, r = tl & 31;
#pragma unroll
                for (int bj = 0; bj < 2; ++bj) { const int cc = (colt & 1023) + bj * HALF + wc * 32 + 8 * fq, h = cc >> 6, d8 = cc & 63, bh = b * 16 + h;
                    const f32x4 v0 = acc[ai][bj][m][0] * rs, v1 = acc[ai][bj][m][1] * rs;
                    u32x4 w; w.x = cvt_pk_bf16(v0[0], v0[1]); w.y = cvt_pk_bf16(v0[2], v0[3]); w.z = cvt_pk_bf16(v1[0], v1[1]); w.w = cvt_pk_bf16(v1[2], v1[3]);
                    if (region < 2) { const int ks = d8 >> 4, hh = (d8 >> 3) & 1;
                        *(u32x4*)(base + ((size_t)(((bh * 128 + tile) * 4 + ks) * 64 + hh * 32 + r) << 3)) = w;
                    } else { const int dt = d8 >> 5, g = (d8 >> 3) & 3; bf16_t* p = base + ((size_t)((((bh * 128 + tile) * 2 + dt) * 4 + g) * 64 + r) << 2);
                        *(unsigned long long*)p = (unsigned long long)w.x | ((unsigned long long)w.y << 32);
                        *(unsigned long long*)(p + 128) = (unsigned long long)w.z | ((unsigned long long)w.w << 32); } }
                asm volatile("" ::: "memory"); }
    }
};
struct EpiVF {
    static constexpr bool PERM = true, AFTER_DRAIN = false;
    bf16_t* VF; const float* ssq;
    __device__ __forceinline__ void operator()(const f32x4 (&acc)[2][2][4][2], const Unit& u, int wr, int wc, int fr, int fq) const {
        const int row0 = u.pm * BM + wr * 64 + fr, col0 = u.pn * BM + wc * 32 + 8 * fq;
        f32x4 cs[2][2];
#pragma unroll
        for (int bj = 0; bj < 2; ++bj)
#pragma unroll
            for (int n = 0; n < 2; ++n) { const f32x4 q = *(const f32x4*)(ssq + col0 + bj * HALF + 4 * n);
#pragma unroll
                for (int e = 0; e < 4; ++e) cs[bj][n][e] = __builtin_amdgcn_rsqf(q[e] * (1.0f / 1024.0f) + 1e-6f); }
#pragma unroll
        for (int ai = 0; ai < 2; ++ai)
#pragma unroll
            for (int m = 0; m < 4; ++m) { const int row = row0 + ai * HALF + m * 16, h = row >> 6, d = row & 63, dt = d >> 5, r = d & 31;
#pragma unroll
                for (int bj = 0; bj < 2; ++bj) { const int col = col0 + bj * HALF, b = col >> 12, tl = col & 4095, kt = tl >> 5, k0 = tl & 31, s = k0 >> 4, half = (k0 >> 3) & 1, bh = b * 16 + h;
                    const f32x4 v0 = acc[ai][bj][m][0] * cs[bj][0], v1 = acc[ai][bj][m][1] * cs[bj][1];
                    bf16_t* p = VF + (((size_t)((((bh * 128 + kt) * 2 + dt) * 2 + s) * 64 + r)) << 3) + 4 * half;
                    *(unsigned long long*)p = (unsigned long long)cvt_pk_bf16(v0[0], v0[1]) | ((unsigned long long)cvt_pk_bf16(v0[2], v0[3]) << 32);
                    *(unsigned long long*)(p + 256) = (unsigned long long)cvt_pk_bf16(v1[0], v1[1]) | ((unsigned long long)cvt_pk_bf16(v1[2], v1[3]) << 32); }
                asm volatile("" ::: "memory"); }
    }
};
struct EpiResidB {
    static constexpr bool PERM = true, AFTER_DRAIN = false;
    const bf16_t* base; bf16_t* outb; float* ssq; int ldc;
    __device__ __forceinline__ void operator()(const f32x4 (&acc)[2][2][4][2], const Unit& u, int wr, int wc, int fr, int fq) const {
        const int row0 = u.pm * BM + wr * 64 + fr, col0 = u.pn * BM + wc * 32 + 8 * fq;
        u32x4 rb[2][4][2];
#pragma unroll
        for (int ai = 0; ai < 2; ++ai)
#pragma unroll
            for (int m = 0; m < 4; ++m)
#pragma unroll
                for (int bj = 0; bj < 2; ++bj) rb[ai][m][bj] = __builtin_nontemporal_load((const u32x4*)(base + (size_t)(row0 + ai * HALF + m * 16) * ldc + col0 + bj * HALF));
        asm volatile("" ::: "memory");
#pragma unroll
        for (int ai = 0; ai < 2; ++ai)
#pragma unroll
            for (int m = 0; m < 4; ++m) { const int row = row0 + ai * HALF + m * 16; float s = 0.f;
#pragma unroll
                for (int bj = 0; bj < 2; ++bj) { const u32x4 w = rb[ai][m][bj];
                    const f32x4 v0 = acc[ai][bj][m][0] + (f32x4){__uint_as_float(w.x << 16), __uint_as_float(w.x & 0xffff0000u), __uint_as_float(w.y << 16), __uint_as_float(w.y & 0xffff0000u)};
                    const f32x4 v1 = acc[ai][bj][m][1] + (f32x4){__uint_as_float(w.z << 16), __uint_as_float(w.z & 0xffff0000u), __uint_as_float(w.w << 16), __uint_as_float(w.w & 0xffff0000u)};
                    s += ((v0[0] * v0[0] + v0[1] * v0[1]) + (v0[2] * v0[2] + v0[3] * v0[3])) + ((v1[0] * v1[0] + v1[1] * v1[1]) + (v1[2] * v1[2] + v1[3] * v1[3]));
                    u32x4 o; o.x = cvt_pk_bf16(v0[0], v0[1]); o.y = cvt_pk_bf16(v0[2], v0[3]); o.z = cvt_pk_bf16(v1[0], v1[1]); o.w = cvt_pk_bf16(v1[2], v1[3]);
                    *(u32x4*)(outb + (size_t)row * ldc + col0 + bj * HALF) = o; }
                s += __shfl_xor(s, 16); s += __shfl_xor(s, 32);
                if (fq == 0) atomicAdd(ssq + row, s); }
    }
};
template <bool BB, bool WF, bool WB> struct EpiResid {
    static constexpr bool PERM = false, AFTER_DRAIN = false;
    const void* base; float* out; bf16_t* outb; float* ssq; int ldc;
    __device__ __forceinline__ void operator()(const f32x4 (&acc)[2][2][4][2], const Unit& u, int wr, int wc, int fr, int fq) const {
        const int row0 = u.pm * BM + wr * 64 + fr, col0 = u.pn * BM + wc * 32 + 4 * fq;
        unsigned long long rb[2][4][2][2];
        if (BB) {
#pragma unroll
            for (int ai = 0; ai < 2; ++ai)
#pragma unroll
                for (int m = 0; m < 4; ++m)
#pragma unroll
                    for (int bj = 0; bj < 2; ++bj)
#pragma unroll
                        for (int n = 0; n < 2; ++n) rb[ai][m][bj][n] = *(const unsigned long long*)((const bf16_t*)base + (size_t)(row0 + ai * HALF + m * 16) * ldc + col0 + bj * HALF + n * 16);
            asm volatile("" ::: "memory"); }
#pragma unroll
        for (int ai = 0; ai < 2; ++ai)
#pragma unroll
            for (int m = 0; m < 4; ++m) { const int row = row0 + ai * HALF + m * 16; const size_t off = (size_t)row * ldc + col0; float s = 0.f;
#pragma unroll
                for (int bj = 0; bj < 2; ++bj)
#pragma unroll
                    for (int n = 0; n < 2; ++n) { f32x4 bs;
                        if (BB) { const unsigned long long rw = rb[ai][m][bj][n]; const unsigned lo = (unsigned)rw, hi = (unsigned)(rw >> 32);
                            bs = (f32x4){__uint_as_float(lo << 16), __uint_as_float(lo & 0xffff0000u), __uint_as_float(hi << 16), __uint_as_float(hi & 0xffff0000u)}; }
                        else bs = *(const f32x4*)((const float*)base + off + bj * HALF + n * 16);
                        const f32x4 v = bs + acc[ai][bj][m][n];
                        if (WF) *(f32x4*)(out + off + bj * HALF + n * 16) = v;
                        s += (v[0] * v[0] + v[1] * v[1]) + (v[2] * v[2] + v[3] * v[3]);
                        if (WB) { unsigned lo = cvt_pk_bf16(v[0], v[1]), hi = cvt_pk_bf16(v[2], v[3]); *(unsigned long long*)(outb + off + bj * HALF + n * 16) = (unsigned long long)lo | ((unsigned long long)hi << 32); } }
                s += __shfl_xor(s, 16); s += __shfl_xor(s, 32);
                if (fq == 0) atomicAdd(ssq + row, s);
                asm volatile("" ::: "memory"); }
    }
};
template <class Epi, class Sched, bool ALIGN_EPI = false, bool SP2 = false>
__device__ __forceinline__ void gemm_phase(PG8_LAS unsigned char* lds, const Gemm g, const Sched& S, const Epi& E) {
    const int tid = threadIdx.x, wid = __builtin_amdgcn_readfirstlane(tid >> 6), lane = tid & 63, wr = wid >> 2, wc = wid & 3, fr = lane & 15, fq = lane >> 4;
    const int K = g.K, nt = K / BK;
    unsigned voffA[2], voffB[2];
#pragma unroll
    for (int i = 0; i < 2; ++i) { int R, C; stage_rc(tid * 16 + i * 8192, R, C); const int Rb = Epi::PERM ? ((R & ~31) + perm32(R & 31)) : R;
        voffA[i] = (unsigned)(R * K + C) * 2u; voffB[i] = (unsigned)(Rb * K + C) * 2u; }
    const size_t kstep = (size_t)(BK * 2);
    const size_t hstep = (size_t)HALF * K * 2;
    const size_t tstep = 2 * hstep;
    const unsigned ldsw = (unsigned)wid * 1024u;
    const int aoff = lds_byte(wr * 64 + fr, fq * 8), boff = lds_byte(wc * 32 + fr, fq * 8);
#define PG8_SA(b, h) (((b) * 2 + (h)) * HTB)
#define PG8_SB(b, h) ((4 + (b) * 2 + (h)) * HTB)
#define PG8_STAGE(bufoff, gbase, voff) do { _Pragma("unroll") for (int _i = 0; _i < 2; ++_i) \
        __builtin_amdgcn_global_load_lds((const unsigned*)((const char*)(gbase) + (voff)[_i]), (PG8_LAS unsigned*)(lds + (bufoff) + ldsw + _i * 8192), 16, 0, 0); } while (0)
#define PG8_LDA(dst, b, h) do { _Pragma("unroll") for (int m = 0; m < 4; ++m) _Pragma("unroll") for (int k = 0; k < 2; ++k) dst[m][k] = *(const PG8_LAS bf16x8*)(lds + PG8_SA(b, h) + aoff + m * 2048 + k * 1024); } while (0)
#define PG8_LDB(dst, b, h) do { _Pragma("unroll") for (int n = 0; n < 2; ++n) _Pragma("unroll") for (int k = 0; k < 2; ++k) dst[n][k] = *(const PG8_LAS bf16x8*)(lds + PG8_SB(b, h) + boff + n * 2048 + k * 1024); } while (0)
#define PG8_MMA(ai, bj, At, Bt) do { __builtin_amdgcn_s_setprio(1); _Pragma("unroll") for (int m = 0; m < 4; ++m) _Pragma("unroll") for (int n = 0; n < 2; ++n) _Pragma("unroll") for (int k = 0; k < 2; ++k) \
        acc[ai][bj][m][n] = __builtin_amdgcn_mfma_f32_16x16x32_bf16(Bt[n][k], At[m][k], acc[ai][bj][m][n], 0, 0, 0); __builtin_amdgcn_s_setprio(0); } while (0)
#define PG8_WAIT_V(n) asm volatile("s_waitcnt vmcnt(" #n ")" ::: "memory")
#define PG8_WAIT_L(n) asm volatile("s_waitcnt lgkmcnt(" #n ")" ::: "memory")
#define PG8_BAR __builtin_amdgcn_s_barrier()
#define PG8_SCHED __builtin_amdgcn_sched_barrier(0)
    Unit cur, nxt; int ui = 0;
    if (!S.next(0, cur)) return;
    f32x4 acc[2][2][4][2];
#pragma unroll
    for (int a = 0; a < 2; ++a)
#pragma unroll
        for (int b = 0; b < 2; ++b)
#pragma unroll
            for (int m = 0; m < 4; ++m)
#pragma unroll
                for (int n = 0; n < 2; ++n) acc[a][b][m][n] = (f32x4){0.f, 0.f, 0.f, 0.f};
    bf16x8 At[4][2], B0[2][2], B1[2][2];
    const char* cA = (const char*)g.A + (size_t)cur.pm * tstep; const char* cB = (const char*)g.Bt + (size_t)cur.pn * tstep;
    S.a_ready(cur);
    if constexpr (SP2) {
        PG8_STAGE(PG8_SB(0, 0), cB, voffB); PG8_STAGE(PG8_SB(0, 1), cB + hstep, voffB); PG8_STAGE(PG8_SA(0, 0), cA, voffA); PG8_STAGE(PG8_SA(0, 1), cA + hstep, voffA);
        if (wr == 1) PG8_BAR;
        PG8_WAIT_V(2); PG8_BAR;
        PG8_STAGE(PG8_SB(1, 0), cB + kstep, voffB); PG8_STAGE(PG8_SA(1, 0), cA + kstep, voffA); PG8_STAGE(PG8_SB(1, 1), cB + hstep + kstep, voffB);
        PG8_WAIT_V(6); PG8_BAR;
    } else {
        PG8_STAGE(PG8_SB(0, 0), cB, voffB); PG8_STAGE(PG8_SA(0, 0), cA, voffA); PG8_STAGE(PG8_SB(0, 1), cB + hstep, voffB); PG8_STAGE(PG8_SA(0, 1), cA + hstep, voffA);
        if (wr == 1) PG8_BAR;
        PG8_WAIT_V(4); PG8_BAR;
        PG8_STAGE(PG8_SB(1, 0), cB + kstep, voffB); PG8_STAGE(PG8_SA(1, 0), cA + kstep, voffA); PG8_STAGE(PG8_SB(1, 1), cB + hstep + kstep, voffB);
        PG8_WAIT_V(6); PG8_BAR;
    }
    for (;;) {
        const bool has_next = S.next(ui + 1, nxt);
        const char* nA = has_next ? (const char*)g.A + (size_t)nxt.pm * tstep : cA; const char* nB = has_next ? (const char*)g.Bt + (size_t)nxt.pn * tstep : cB;
        for (int t = 0; t < nt; t += 2) {
            const bool last = (t == nt - 2);
            const char* a1 = cA + (size_t)(t + 1) * kstep;
            const char* a2 = last ? nA : cA + (size_t)(t + 2) * kstep; const char* b2 = last ? nB : cB + (size_t)(t + 2) * kstep;
            const char* a3 = a2 + kstep; const char* b3 = b2 + kstep;
            if (last && has_next) S.a_ready(nxt);
            if constexpr (SP2) {
            PG8_LDB(B0, 0, 0); PG8_LDB(B1, 0, 1); PG8_SCHED; PG8_LDA(At, 0, 0); PG8_STAGE(PG8_SA(1, 1), a1 + hstep, voffA);
            PG8_WAIT_V(8); PG8_WAIT_L(0); PG8_BAR; PG8_MMA(0, 0, At, B0); PG8_MMA(0, 1, At, B1); PG8_BAR; PG8_SCHED;
            PG8_LDA(At, 0, 1); PG8_STAGE(PG8_SB(0, 0), b2, voffB); PG8_STAGE(PG8_SB(0, 1), b2 + hstep, voffB); PG8_STAGE(PG8_SA(0, 0), a2, voffA);
            PG8_WAIT_V(8); PG8_WAIT_L(0); PG8_BAR; PG8_MMA(1, 0, At, B0); PG8_MMA(1, 1, At, B1); PG8_BAR; PG8_SCHED;
            PG8_LDB(B0, 1, 0); PG8_LDB(B1, 1, 1); PG8_SCHED; PG8_LDA(At, 1, 0); PG8_STAGE(PG8_SA(0, 1), a2 + hstep, voffA);
            PG8_WAIT_V(8); PG8_WAIT_L(0); PG8_BAR; PG8_MMA(0, 0, At, B0); PG8_MMA(0, 1, At, B1); PG8_BAR; PG8_SCHED;
            PG8_LDA(At, 1, 1); PG8_STAGE(PG8_SB(1, 0), b3, voffB); PG8_STAGE(PG8_SB(1, 1), b3 + hstep, voffB); PG8_STAGE(PG8_SA(1, 0), a3, voffA);
            PG8_WAIT_V(8); PG8_WAIT_L(0); PG8_BAR; PG8_MMA(1, 0, At, B0); PG8_MMA(1, 1, At, B1); PG8_BAR; PG8_SCHED;
            } else {
            PG8_LDB(B0, 0, 0); PG8_SCHED; PG8_LDA(At, 0, 0); PG8_STAGE(PG8_SA(1, 1), a1 + hstep, voffA);
            PG8_WAIT_L(8); PG8_BAR; PG8_WAIT_L(0); PG8_MMA(0, 0, At, B0); PG8_BAR; PG8_SCHED;
            PG8_LDB(B1, 0, 1); PG8_STAGE(PG8_SB(0, 0), b2, voffB);
            PG8_BAR; PG8_WAIT_L(0); PG8_MMA(0, 1, At, B1); PG8_BAR;
            PG8_LDA(At, 0, 1); PG8_STAGE(PG8_SA(0, 0), a2, voffA);
            PG8_BAR; PG8_WAIT_L(0); PG8_MMA(1, 0, At, B0); PG8_BAR; PG8_SCHED;
            PG8_STAGE(PG8_SB(0, 1), b2 + hstep, voffB);
            PG8_WAIT_V(6); PG8_BAR; PG8_MMA(1, 1, At, B1); PG8_BAR;
            PG8_LDB(B0, 1, 0); PG8_SCHED; PG8_LDA(At, 1, 0); PG8_STAGE(PG8_SA(0, 1), a2 + hstep, voffA);
            PG8_WAIT_L(8); PG8_BAR; PG8_WAIT_L(0); PG8_MMA(0, 0, At, B0); PG8_BAR; PG8_SCHED;
            PG8_LDB(B1, 1, 1); PG8_STAGE(PG8_SB(1, 0), b3, voffB);
            PG8_BAR; PG8_WAIT_L(0); PG8_MMA(0, 1, At, B1); PG8_BAR;
            PG8_LDA(At, 1, 1); PG8_STAGE(PG8_SA(1, 0), a3, voffA);
            PG8_BAR; PG8_WAIT_L(0); PG8_MMA(1, 0, At, B0); PG8_BAR; PG8_SCHED;
            PG8_STAGE(PG8_SB(1, 1), b3 + hstep, voffB);
            PG8_WAIT_V(6); PG8_BAR; PG8_MMA(1, 1, At, B1); PG8_BAR;
            }
        }
        if constexpr (ALIGN_EPI) { if (wr == 0) PG8_BAR; }
        if constexpr (!Epi::AFTER_DRAIN) { E(acc, cur, wr, wc, fr, fq); S.done(cur); }
        if (!has_next) break;
#pragma unroll
        for (int a = 0; a < 2; ++a)
#pragma unroll
            for (int b = 0; b < 2; ++b)
#pragma unroll
                for (int m = 0; m < 4; ++m)
#pragma unroll
                    for (int n = 0; n < 2; ++n) acc[a][b][m][n] = (f32x4){0.f, 0.f, 0.f, 0.f};
        cur = nxt; cA = nA; cB = nB; ++ui;
        if constexpr (ALIGN_EPI) { if (wr == 1) PG8_BAR; }
    }
    PG8_WAIT_V(0);
    if constexpr (!ALIGN_EPI) { if (wr == 0) PG8_BAR; }
    PG8_BAR;
    if constexpr (Epi::AFTER_DRAIN) { E.fused(acc, cur, wr, wc, fr, fq, lds, wid, lane); S.done(cur); }
#undef PG8_SA
#undef PG8_SB
#undef PG8_STAGE
#undef PG8_LDA
#undef PG8_LDB
#undef PG8_MMA
#undef PG8_WAIT_V
#undef PG8_WAIT_L
#undef PG8_BAR
#undef PG8_SCHED
}
}
#define LAS __attribute__((address_space(3)))
typedef unsigned short bf16;
typedef unsigned v4u __attribute__((ext_vector_type(4)));
typedef unsigned v2u __attribute__((ext_vector_type(2)));
typedef float f32x4 __attribute__((ext_vector_type(4)));
typedef float f32x16 __attribute__((ext_vector_type(16)));
typedef short bf16x8 __attribute__((ext_vector_type(8)));
typedef float f32x2_t __attribute__((ext_vector_type(2))); typedef __bf16 bf16x2_t __attribute__((ext_vector_type(2)));
constexpr int NWAVES = 8, NT = 512;
constexpr int BATCH = 4, SEQ = 4096, D = 1024, M = BATCH * SEQ;
constexpr int LH = 16, LB = 80, LW = 1280;
constexpr int NIN0 = 2 * LW;
constexpr int AH = 16, HD = 64, AW = 1024, NIN1 = 4 * AW;
constexpr int NQKG = 3 * AW;
constexpr int CHUNK = 256, NCHUNK = SEQ / CHUNK;
constexpr float LOG2E = 1.4426950408889634f, LN2 = 0.6931471805599453f;
constexpr float QSCALE = 0.125f * LOG2E;
constexpr size_t MiB = 1u << 20;
constexpr size_t WS_SSQ0 = 1 * MiB, WS_SSQ1 = WS_SSQ0 + 65536, WS_SSQ2 = WS_SSQ1 + 65536, WS_SUM = WS_SSQ2 + 65536;
constexpr size_t WS_PAR = WS_SUM + 655360;
constexpr size_t WS_W0T = 2 * MiB, WS_WO0T = 8 * MiB, WS_W1T = 11 * MiB, WS_WO1T = 20 * MiB, WS_WGF = 22 * MiB;
constexpr size_t WS_X = 23 * MiB;
constexpr size_t WS_ZERO = WS_X + 524288;
constexpr size_t WS_XB = 24 * MiB;
constexpr size_t WS_U0 = 56 * MiB;
constexpr size_t WS_YG = 140 * MiB;
constexpr size_t WS_U1 = 56 * MiB;
constexpr size_t WS_VT = 156 * MiB;
constexpr size_t WS_OG = 188 * MiB;
constexpr size_t WS_END = 220 * MiB;
static_assert(WS_PAR + 40960 <= WS_W0T && WS_U0 + (size_t)M * NIN0 * 2 <= WS_YG && WS_YG + (size_t)M * LW * 2 <= WS_OG && WS_U1 + (size_t)M * NQKG * 2 <= WS_VT && WS_VT + (size_t)M * AW * 2 <= WS_OG, "ws map");
constexpr int LDS_BYTES = 135168;

__device__ __forceinline__ unsigned pk2(float lo, float hi) { f32x2_t v = {lo, hi}; bf16x2_t b = __builtin_convertvector(v, bf16x2_t); return __builtin_bit_cast(unsigned, b); }
__device__ __forceinline__ float bflo(unsigned u) { return __uint_as_float(u << 16); }
__device__ __forceinline__ float bfhi(unsigned u) { return __uint_as_float(u & 0xffff0000u); }
__device__ __forceinline__ float ex2(float x) { return __builtin_amdgcn_exp2f(x); }
__device__ __forceinline__ float rcpf_(float x) { return __builtin_amdgcn_rcpf(x); }
__device__ __forceinline__ float sigmoid_(float x) { return rcpf_(1.0f + ex2(-LOG2E * x)); }
__device__ __forceinline__ float wave_sum(float v) {
#pragma unroll
    for (int o = 1; o < 64; o <<= 1) v += __shfl_xor(v, o);
    return v;
}
#define LDS_WAIT() asm volatile("s_waitcnt lgkmcnt(0)" ::: "memory")
#define MFMA32(a, b, c) __builtin_amdgcn_mfma_f32_32x32x16_bf16((a), (b), (c), 0, 0, 0)
__device__ __forceinline__ int crow(int reg, int h) { return (reg & 3) + 8 * (reg >> 2) + 4 * h; }

__device__ __forceinline__ void p0_transpose_item(const float* W, int K, int N, bf16* WT, const float* ks, int radd, LAS float* scr, int kb, int nb, int lane) {
    const int k0 = 64 * kb, n0 = 32 * nb;
#pragma unroll 8
    for (int i = 0; i < 32; ++i) { const int kk = 2 * i + (lane >> 5); const float s = ks ? ks[k0 + kk] : 1.0f; scr[kk * 33 + (lane & 31)] = __builtin_nontemporal_load(W + (size_t)(k0 + kk) * N + n0 + (lane & 31)) * s; }
    LDS_WAIT(); asm volatile("" ::: "memory");
    const int c = lane & 7;
#pragma unroll
    for (int j = 0; j < 4; ++j) { const int n = (lane >> 3) + 8 * j; const LAS float* s = scr + (8 * c) * 33 + n;
        v4u o; o.x = pk2(s[0 * 33], s[1 * 33]); o.y = pk2(s[2 * 33], s[3 * 33]); o.z = pk2(s[4 * 33], s[5 * 33]); o.w = pk2(s[6 * 33], s[7 * 33]);
        *(v4u*)(WT + (size_t)(radd + n0 + n) * K + k0 + 8 * c) = o; }
    LDS_WAIT(); asm volatile("" ::: "memory");
}
struct Ptrs {
    const float *x, *norm_g, *fng, *lwin, *lcw, *lcb, *lwg, *lbg, *llam, *lwout, *swin, *swout;
    float* out; unsigned char* ws;
};
__device__ __forceinline__ void p0_prologue(const Ptrs& P, LAS unsigned char* lds, int gw, int NGW, int wave, int lane, int gtid, int GT, int part) {
    LAS float* scr = (LAS float*)(lds + wave * 16384);
    bf16* W0T = (bf16*)(P.ws + WS_W0T); bf16* WO0T = (bf16*)(P.ws + WS_WO0T); bf16* W1T = (bf16*)(P.ws + WS_W1T); bf16* WO1T = (bf16*)(P.ws + WS_WO1T);
    constexpr int I0 = (D / 64) * (NIN0 / 32), I1 = (LW / 64) * (D / 32), I2 = (D / 64) * (NIN1 / 32), I3 = (AW / 64) * (D / 32);
    const int it_lo = part == 2 ? I0 + I1 : 0, it_hi = part == 1 ? I0 + I1 : I0 + I1 + I2 + I3;
    for (int it = it_lo + gw; it < it_hi; it += NGW) {
        int r = it;
        if (r < I0) { const int nblk = NIN0 / 32; p0_transpose_item(P.lwin, D, NIN0, W0T, P.norm_g, 0, scr, r / nblk, r % nblk, lane); continue; } r -= I0;
        if (r < I1) { const int nblk = D / 32; p0_transpose_item(P.lwout, LW, D, WO0T, nullptr, 0, scr, r / nblk, r % nblk, lane); continue; } r -= I1;
        if (r < I2) { const int nblk = NIN1 / 32, nb = r % nblk, n0 = 32 * nb;
            const int radd = (n0 < 2 * AW) ? 0 : (n0 < 3 * AW ? AW : -AW);
            p0_transpose_item(P.swin, D, NIN1, W1T, P.norm_g + D, radd, scr, r / nblk, nb, lane); continue; } r -= I2;
        { const int nblk = D / 32; p0_transpose_item(P.swout, AW, D, WO1T, nullptr, 0, scr, r / nblk, r % nblk, lane); }
    }
    if (part == 2) return;
    bf16* WGF = (bf16*)(P.ws + WS_WGF);
    for (int g = gtid; g < LH * 6 * 6 * 64; g += GT) {
        const int l = g & 63, s = (g >> 6) % 6, tile = (g / 384) % 6, hd = g / 2304, r = l & 31, hh = l >> 5;
        const int cc = 32 * (tile % 3) + r, col = tile < 3 ? cc : LB + cc; float v[8];
#pragma unroll
        for (int j = 0; j < 8; ++j) { const int ch = 16 * s + 8 * (j >> 2) + 4 * hh + (j & 3);
            v[j] = 0.0f;
            if (cc < LB) { if (s < 5) v[j] = -LOG2E * P.lwg[((size_t)hd * LB + ch) * (2 * LB) + col]; else if (j == 0 && hh == 0) v[j] = -LOG2E * P.lbg[hd * 2 * LB + col]; } }
        v4u o; o.x = pk2(v[0], v[1]); o.y = pk2(v[2], v[3]); o.z = pk2(v[4], v[5]); o.w = pk2(v[6], v[7]);
        *(v4u*)(WGF + (size_t)g * 8) = o;
    }
    float* PAR = (float*)(P.ws + WS_PAR);
    for (int g = gtid; g < LH * 8 * LB; g += GT) {
        const int ch = g % LB, row = (g / LB) % 8, hd = g / (8 * LB), c = hd * LB + ch; float v;
        if (row < 4) v = P.lcw[row * LW + c];
        else if (row == 4) v = P.lcb[c];
        else if (row == 5) v = P.lbg[hd * 2 * LB + ch];
        else if (row == 6) v = P.lbg[hd * 2 * LB + LB + ch];
        else { const float lam = P.llam[c]; v = 8.0f * LOG2E * (fminf(lam, 0.0f) - log1pf(expf(-fabsf(lam)))); }
        PAR[g] = v;
    }
    float* ssq0 = (float*)(P.ws + WS_SSQ0); float* ssq1 = (float*)(P.ws + WS_SSQ1); float* ssq2 = (float*)(P.ws + WS_SSQ2);
    for (int g = gtid; g < M; g += GT) { ssq1[g] = 0.0f; ssq2[g] = 0.0f; }
    { unsigned long long* XS = (unsigned long long*)(P.ws + WS_X); for (int g = gtid; g < M * 4 + 1024; g += GT) XS[g] = 0ull; }
    { unsigned long long* GR = (unsigned long long*)(P.ws + WS_SUM); for (int g = gtid; g < 64 * NCHUNK * LB; g += GT) GR[g] = 0ull; }
    bf16* XB = (bf16*)(P.ws + WS_XB);
    for (int m = gw; m < M; m += NGW) {
        const f32x4* xr = (const f32x4*)(P.x + (size_t)m * D) + lane; unsigned long long* o8 = (unsigned long long*)(XB + (size_t)m * D) + lane;
        f32x4 v[4]; float s = 0.f;
#pragma unroll
        for (int j = 0; j < 4; ++j) { v[j] = __builtin_nontemporal_load(xr + 64 * j); s += (v[j].x * v[j].x + v[j].y * v[j].y) + (v[j].z * v[j].z + v[j].w * v[j].w); }
#pragma unroll
        for (int j = 0; j < 4; ++j) o8[64 * j] = (unsigned long long)pk2(v[j].x, v[j].y) | ((unsigned long long)pk2(v[j].z, v[j].w) << 32);
        s = wave_sum(s); if (lane == 0) ssq0[m] = s;
    }
}

constexpr int L_WGF = 0, L_PAR = 36864, L_COMP = 39424, L_HIN = 44544;
#define LRU_DPP4(ctrl) \
    "v_fmac_f32_dpp %4, %4, %0 " ctrl "\n\tv_fmac_f32_dpp %5, %5, %1 " ctrl "\n\tv_fmac_f32_dpp %6, %6, %2 " ctrl "\n\tv_fmac_f32_dpp %7, %7, %3 " ctrl "\n\t" \
    "v_mul_f32_dpp %0, %0, %0 " ctrl "\n\tv_mul_f32_dpp %1, %1, %1 " ctrl "\n\tv_mul_f32_dpp %2, %2, %2 " ctrl "\n\tv_mul_f32_dpp %3, %3, %3 " ctrl "\n\t"
__device__ __forceinline__ void lru_phase(const Ptrs& P, LAS unsigned char* lds, int G, int wave, int lane, int tid) {
    const bf16* U0 = (const bf16*)(P.ws + WS_U0); bf16* YG = (bf16*)(P.ws + WS_YG);
    const bf16* WGF = (const bf16*)(P.ws + WS_WGF); const float* PAR = (const float*)(P.ws + WS_PAR); unsigned long long* GR = (unsigned long long*)(P.ws + WS_SUM);
    const int r = lane & 31, hh = lane >> 5;
    { const int hd0 = blockIdx.x & 15;
      const v4u* src = (const v4u*)(WGF + (size_t)hd0 * 18432); LAS v4u* dst = (LAS v4u*)(lds + L_WGF);
      for (int i = tid; i < 2304; i += NT) dst[i] = src[i];
      const f32x4* ps = (const f32x4*)(PAR + hd0 * 640); LAS f32x4* pd = (LAS f32x4*)(lds + L_PAR);
      if (tid < 160) pd[tid] = ps[tid]; }
    __syncthreads();
    v2u raw[10][4];
#define LRU_LOAD_RAW(uu) do { const int bh_ = (uu) & 63, c_ = (uu) >> 6, b_ = bh_ >> 4, hd_ = bh_ & 15, tl_ = c_ * CHUNK + wave * 32 + r; \
        _Pragma("unroll") for (int tap = 0; tap < 4; ++tap) { const int tk = tl_ - 3 + tap;        \
            const bf16* tp_ = tk >= 0 ? U0 + ((size_t)(((b_ * 128 + (tk >> 5)) * 16 + hd_) * 10) * 64 + hh * 32 + (tk & 31)) * 4 : (const bf16*)(P.ws + WS_ZERO); \
            _Pragma("unroll") for (int gq = 0; gq < 10; ++gq) raw[gq][tap] = *(const v2u*)(tp_ + gq * 256); } \
        asm volatile("" ::: "memory"); } while (0)
    if ((int)blockIdx.x < 64 * NCHUNK) LRU_LOAD_RAW((int)blockIdx.x);
    for (int u = blockIdx.x; u < 64 * NCHUNK; u += G) {
        const int bh = u & 63, c = u >> 6, b = bh >> 4, hd = bh & 15;
        const LAS float* par = (const LAS float*)(lds + L_PAR);
        const int tloc = c * CHUNK + wave * 32 + r; const size_t trow = (size_t)b * SEQ + tloc;
        float xc[5][2][4]; bf16x8 xf[5];
        {
          __builtin_amdgcn_sched_barrier(0);
#pragma unroll
          for (int s = 0; s < 5; ++s) { unsigned pkd[4];
#pragma unroll
              for (int half = 0; half < 2; ++half) { const int ch0 = 16 * s + 8 * half;
                  const f32x4 cb = *(const LAS f32x4*)(par + 4 * LB + ch0 + 4 * hh);
                  float a0 = cb[0], a1 = cb[1], a2 = cb[2], a3 = cb[3];
#pragma unroll
                  for (int tap = 0; tap < 4; ++tap) { const v2u rw = raw[s * 2 + half][tap];
                      const f32x4 cw = *(const LAS f32x4*)(par + tap * LB + ch0 + 4 * hh);
                      float c0 = cw[0], c1 = cw[1], c2 = cw[2], c3 = cw[3]; asm("" : "+v"(c0), "+v"(c1), "+v"(c2), "+v"(c3));
                      a0 = __builtin_fmaf(c0, bflo(rw.x), a0); a1 = __builtin_fmaf(c1, bfhi(rw.x), a1); a2 = __builtin_fmaf(c2, bflo(rw.y), a2); a3 = __builtin_fmaf(c3, bfhi(rw.y), a3); }
                  asm volatile("" : "+v"(a0), "+v"(a1), "+v"(a2), "+v"(a3));
                  xc[s][half][0] = a0; xc[s][half][1] = a1; xc[s][half][2] = a2; xc[s][half][3] = a3;
                  pkd[2 * half] = pk2(a0, a1); pkd[2 * half + 1] = pk2(a2, a3); __builtin_amdgcn_sched_barrier(0); }
              v4u t = {pkd[0], pkd[1], pkd[2], pkd[3]}; xf[s] = __builtin_bit_cast(bf16x8, t); __builtin_amdgcn_sched_barrier(0); } }
        float Av[5][2][4];
        const v4u xone_u = {hh == 0 ? 0x3F80u : 0u, 0u, 0u, 0u}; const bf16x8 xone = __builtin_bit_cast(bf16x8, xone_u);
#pragma unroll
        for (int mt = 0; mt < 3; ++mt) {
            f32x16 gr, gi;
#pragma unroll
            for (int i = 0; i < 16; ++i) { gr[i] = 0.f; gi[i] = 0.f; }
            const LAS bf16x8* wa = (const LAS bf16x8*)(lds + L_WGF) + (size_t)(mt * 6) * 64 + lane;
            const LAS bf16x8* wb = (const LAS bf16x8*)(lds + L_WGF) + (size_t)((3 + mt) * 6) * 64 + lane;
#pragma unroll
            for (int s = 0; s < 5; ++s) { gr = MFMA32(wa[s * 64], xf[s], gr); gi = MFMA32(wb[s * 64], xf[s], gi); }
            gr = MFMA32(wa[5 * 64], xone, gr); gi = MFMA32(wb[5 * 64], xone, gi);
            __builtin_amdgcn_sched_barrier(0);
#pragma unroll
            for (int i4 = 0; i4 < 4; ++i4) { if (mt == 2 && i4 >= 2) continue;
                const int s = 2 * mt + (i4 >> 1), half = i4 & 1, ch0 = 16 * s + 8 * half + 4 * hh;
                const f32x4 ls2 = *(const LAS f32x4*)(par + 7 * LB + ch0);
                float A4[4], B4[4];
#pragma unroll
                for (int q = 0; q < 4; ++q) { const int i = 4 * i4 + q;
                    const float rg = rcpf_(1.0f + ex2(gr[i])), ig = rcpf_(1.0f + ex2(gi[i]));
                    const float la2 = ls2[q] * rg, a = ex2(la2), xx = (2.0f * LN2) * la2;
                    const float poly = -xx * (1.0f + xx * (0.5f + xx * ((1.0f / 6.0f) + xx * ((1.0f / 24.0f) + xx * (1.0f / 120.0f)))));
                    const float om = (xx > -0.25f) ? poly : (1.0f - a * a);
                    A4[q] = a; B4[q] = __builtin_amdgcn_sqrtf(om) * (ig * xc[s][half][q]); }
                asm volatile("s_nop 1\n\t"
                    LRU_DPP4("row_shr:1 row_mask:0xf bank_mask:0xf") LRU_DPP4("row_shr:2 row_mask:0xf bank_mask:0xf") LRU_DPP4("row_shr:4 row_mask:0xf bank_mask:0xf")
                    LRU_DPP4("row_shr:8 row_mask:0xf bank_mask:0xf") LRU_DPP4("row_bcast:15 row_mask:0xa bank_mask:0xf")
                    : "+v"(A4[0]), "+v"(A4[1]), "+v"(A4[2]), "+v"(A4[3]), "+v"(B4[0]), "+v"(B4[1]), "+v"(B4[2]), "+v"(B4[3]));
#pragma unroll
                for (int q = 0; q < 4; ++q) { Av[s][half][q] = A4[q]; xc[s][half][q] = B4[q]; }
                __builtin_amdgcn_sched_barrier(0); }
        }
        v2u graw_[10];
        { const bf16* gp = U0 + (size_t)M * LW + ((size_t)(((b * 128 + (tloc >> 5)) * 16 + hd) * 10) * 64 + lane) * 4;
#pragma unroll
          for (int gq = 0; gq < 10; ++gq) graw_[gq] = __builtin_nontemporal_load((const v2u*)(gp + gq * 256)); }
        if (r == 31) { LAS float* cp = (LAS float*)(lds + L_COMP) + wave * 160 + 4 * hh;
#pragma unroll
            for (int s = 0; s < 5; ++s)
#pragma unroll
                for (int half = 0; half < 2; ++half) { const int ch0 = 16 * s + 8 * half;
                    *(LAS f32x4*)(cp + ch0) = (f32x4){Av[s][half][0], Av[s][half][1], Av[s][half][2], Av[s][half][3]};
                    *(LAS f32x4*)(cp + 80 + ch0) = (f32x4){xc[s][half][0], xc[s][half][1], xc[s][half][2], xc[s][half][3]}; } }
        { const int un = u + G < 64 * NCHUNK ? u + G : u; LRU_LOAD_RAW(un); }
        unsigned long long gv_early = 0ull;
        if (tid < LB && c > 0) gv_early = __hip_atomic_load(GR + ((size_t)bh * NCHUNK + (c - 1)) * LB + tid, __ATOMIC_RELAXED, __HIP_MEMORY_SCOPE_AGENT);
        __syncthreads();
        if (tid < LB) { const LAS float* cp = (const LAS float*)(lds + L_COMP) + tid;
            float Au = 1.0f, Bu = 0.0f;
#pragma unroll
            for (int w = 0; w < 8; ++w) { const float a = cp[w * 160], bb = cp[w * 160 + 80]; Bu = a * Bu + bb; Au = Au * a; }
            float h = 0.0f;
            if (c > 0) { unsigned long long* src = GR + ((size_t)bh * NCHUNK + (c - 1)) * LB + tid; unsigned long long v = gv_early; unsigned sp = 0;
                while ((unsigned)(v >> 32) != 1u && ++sp <= (1u << 22)) { __builtin_amdgcn_s_sleep(1); v = __hip_atomic_load(src, __ATOMIC_RELAXED, __HIP_MEMORY_SCOPE_AGENT); }
                h = __uint_as_float((unsigned)v); }
            __hip_atomic_store(GR + ((size_t)bh * NCHUNK + c) * LB + tid, (1ull << 32) | (unsigned long long)__float_as_uint(Au * h + Bu), __ATOMIC_RELAXED, __HIP_MEMORY_SCOPE_AGENT);
            LAS float* hp = (LAS float*)(lds + L_HIN) + tid;
#pragma unroll
            for (int w = 0; w < 8; ++w) { hp[w * 80] = h; h = cp[w * 160] * h + cp[w * 160 + 80]; } }
        __syncthreads();
        { const LAS float* hp = (const LAS float*)(lds + L_HIN) + wave * 80 + 4 * hh;
          bf16* yp = YG + trow * LW + hd * LB + 8 * hh;
#pragma unroll
          for (int s = 0; s < 5; ++s) { v2u pk[2];
#pragma unroll
              for (int half = 0; half < 2; ++half) { const int ch0 = 16 * s + 8 * half;
                  const f32x4 hin = *(const LAS f32x4*)(hp + ch0); const v2u graw = graw_[s * 2 + half];
                  const float g0 = bflo(graw.x), g1 = bfhi(graw.x), g2 = bflo(graw.y), g3 = bfhi(graw.y);
                  const float y0 = (xc[s][half][0] + Av[s][half][0] * hin[0]) * (g0 * sigmoid_(g0));
                  const float y1 = (xc[s][half][1] + Av[s][half][1] * hin[1]) * (g1 * sigmoid_(g1));
                  const float y2 = (xc[s][half][2] + Av[s][half][2] * hin[2]) * (g2 * sigmoid_(g2));
                  const float y3 = (xc[s][half][3] + Av[s][half][3] * hin[3]) * (g3 * sigmoid_(g3));
                  pk[half].x = pk2(y0, y1); pk[half].y = pk2(y2, y3); }
              const auto rx = __builtin_amdgcn_permlane32_swap(pk[0].x, pk[1].x, false, false), ry = __builtin_amdgcn_permlane32_swap(pk[0].y, pk[1].y, false, false);
              const v4u o = {rx[0], ry[0], rx[1], ry[1]};
              *(v4u*)(yp + 16 * s) = o; __builtin_amdgcn_sched_barrier(0); } }
    }
    __syncthreads();
}
__device__ __forceinline__ void attn_phase(const Ptrs& P, int gw, int NGW, int lane) {
    const bf16x8* QF = (const bf16x8*)(P.ws + WS_U1); const bf16x8* KF = QF + (size_t)M * AW / 8; const v2u* GF = (const v2u*)(KF + (size_t)M * AW / 8);
    const bf16x8* VF = (const bf16x8*)(P.ws + WS_VT); bf16* OG = (bf16*)(P.ws + WS_OG);
    const int r = lane & 31, hh = lane >> 5;
    for (int u = gw; u < BATCH * AH * (SEQ / 32); u += NGW) {
        const int qt = u & 127, bhh = u >> 7, b = bhh >> 4, h = bhh & 15;
        const size_t rowbase = (size_t)b * SEQ;
        bf16x8 qf[4], kf[4];
        { const bf16x8* qp = QF + (size_t)(bhh * 128 + qt) * 256 + lane;
#pragma unroll
          for (int ks = 0; ks < 4; ++ks) qf[ks] = __builtin_nontemporal_load(qp + ks * 64); }
        const bf16x8* kbase = KF + (size_t)bhh * 128 * 256 + lane;
        const bf16x8* vbase = VF + (size_t)bhh * 128 * 256 + lane;
        bf16x8 k1[4], k2[4], vf[2][2], v1[2][2];
        { const int q1 = qt > 0 ? qt - 1 : 0, q2 = qt > 1 ? qt - 2 : 0;
#pragma unroll
          for (int ks = 0; ks < 4; ++ks) { kf[ks] = kbase[(size_t)qt * 256 + ks * 64]; k1[ks] = kbase[(size_t)q1 * 256 + ks * 64]; k2[ks] = kbase[(size_t)q2 * 256 + ks * 64]; }
#pragma unroll
          for (int dt = 0; dt < 2; ++dt)
#pragma unroll
              for (int s = 0; s < 2; ++s) { vf[dt][s] = vbase[(size_t)qt * 256 + (dt * 2 + s) * 64]; v1[dt][s] = vbase[(size_t)q1 * 256 + (dt * 2 + s) * 64]; } }
        v2u gq_[8];
        { const v2u* gp_ = GF + (size_t)(bhh * 128 + qt) * 512 + lane;
#pragma unroll
          for (int j = 0; j < 8; ++j) gq_[j] = __builtin_nontemporal_load(gp_ + j * 64); }
        f32x16 o0, o1;
#pragma unroll
        for (int i = 0; i < 16; ++i) { o0[i] = 0.f; o1[i] = 0.f; }
        float Pc = 1.0f;
        for (int kt = qt; kt >= 0; --kt) {
            bf16x8 k3[4], v2[2][2];
            { const int t3 = kt > 2 ? kt - 3 : 0, t2 = kt > 1 ? kt - 2 : 0;
#pragma unroll
              for (int ks = 0; ks < 4; ++ks) k3[ks] = kbase[(size_t)t3 * 256 + ks * 64];
#pragma unroll
              for (int dt = 0; dt < 2; ++dt)
#pragma unroll
                  for (int s = 0; s < 2; ++s) v2[dt][s] = vbase[(size_t)t2 * 256 + (dt * 2 + s) * 64]; }
            f32x16 sa;
#pragma unroll
            for (int i = 0; i < 16; ++i) sa[i] = 0.f;
#pragma unroll
            for (int ks = 0; ks < 4; ++ks) sa = MFMA32(kf[ks], qf[ks], sa);
            float beta[16], f[16];
            const bool diag = (kt == qt);
#pragma unroll
            for (int i = 0; i < 16; ++i) { float ff = rcpf_(1.0f + ex2(sa[i])), bt = 1.0f - ff;
                if (diag) { const bool valid = crow(i, hh) < r; bt = valid ? bt : 0.0f; ff = valid ? ff : 1.0f; }
                beta[i] = bt; f[i] = ff; }
            float gp[4], ot[4], pr[4];
#pragma unroll
            for (int g = 0; g < 4; ++g) { gp[g] = (f[4 * g] * f[4 * g + 1]) * (f[4 * g + 2] * f[4 * g + 3]);
                const auto rr = __builtin_amdgcn_permlane32_swap(__float_as_uint(gp[g]), __float_as_uint(gp[g]), false, false);
                ot[g] = __uint_as_float(rr[1]); pr[g] = __uint_as_float(rr[0]) * __uint_as_float(rr[1]); }
            float suf = Pc; float att[16];
#pragma unroll
            for (int g = 3; g >= 0; --g) { float p = (hh == 0) ? suf * ot[g] : suf;
                att[4 * g + 3] = beta[4 * g + 3] * p; p *= f[4 * g + 3];
                att[4 * g + 2] = beta[4 * g + 2] * p; p *= f[4 * g + 2];
                att[4 * g + 1] = beta[4 * g + 1] * p; p *= f[4 * g + 1];
                att[4 * g] = beta[4 * g] * p;
                suf *= pr[g]; }
            Pc = suf;
#pragma unroll
            for (int i = 0; i < 16; ++i) asm("" : "+v"(att[i]));
            bf16x8 pf[2];
#pragma unroll
            for (int s = 0; s < 2; ++s) { v4u t; t.x = pk2(att[8 * s], att[8 * s + 1]); t.y = pk2(att[8 * s + 2], att[8 * s + 3]); t.z = pk2(att[8 * s + 4], att[8 * s + 5]); t.w = pk2(att[8 * s + 6], att[8 * s + 7]); pf[s] = __builtin_bit_cast(bf16x8, t); }
#pragma unroll
            for (int s = 0; s < 2; ++s) { o0 = MFMA32(vf[0][s], pf[s], o0); o1 = MFMA32(vf[1][s], pf[s], o1); }
#pragma unroll
            for (int ks = 0; ks < 4; ++ks) { kf[ks] = k1[ks]; k1[ks] = k2[ks]; k2[ks] = k3[ks]; }
#pragma unroll
            for (int dt = 0; dt < 2; ++dt)
#pragma unroll
                for (int s = 0; s < 2; ++s) { vf[dt][s] = v1[dt][s]; v1[dt][s] = v2[dt][s]; }
            if (__builtin_amdgcn_ballot_w64(Pc != 0.0f) == 0ull) break;
        }
        const size_t row = rowbase + qt * 32 + r;
        bf16* op = OG + row * AW + h * HD + 8 * hh;
#pragma unroll
        for (int dt = 0; dt < 2; ++dt)
#pragma unroll
            for (int g = 0; g < 4; g += 2) { v2u pk[2];
#pragma unroll
                for (int e = 0; e < 2; ++e) { const v2u graw = gq_[dt * 4 + g + e]; const int i0 = 4 * (g + e);
                    const float g0 = bflo(graw.x), g1 = bfhi(graw.x), g2 = bflo(graw.y), g3 = bfhi(graw.y);
                    const float v0 = dt ? o1[i0] : o0[i0], v1 = dt ? o1[i0 + 1] : o0[i0 + 1], v2 = dt ? o1[i0 + 2] : o0[i0 + 2], v3 = dt ? o1[i0 + 3] : o0[i0 + 3];
                    float w0 = v0 * (g0 * sigmoid_(g0)), w1 = v1 * (g1 * sigmoid_(g1)), w2 = v2 * (g2 * sigmoid_(g2)), w3 = v3 * (g3 * sigmoid_(g3));
                    asm("" : "+v"(w0)); asm("" : "+v"(w1)); asm("" : "+v"(w2)); asm("" : "+v"(w3));
                    pk[e].x = pk2(w0, w1); pk[e].y = pk2(w2, w3); }
                const auto rx = __builtin_amdgcn_permlane32_swap(pk[0].x, pk[1].x, false, false), ry = __builtin_amdgcn_permlane32_swap(pk[0].y, pk[1].y, false, false);
                const v4u o = {rx[0], ry[0], rx[1], ry[1]};
                *(v4u*)(op + dt * 32 + 8 * g) = o; }
    }
}

__device__ __forceinline__ void final_norm(const Ptrs& P, int gw, int NGW, int lane) {
    const float* ssq2 = (const float*)(P.ws + WS_SSQ2);
    f32x4 g[4];
#pragma unroll
    for (int j = 0; j < 4; ++j) g[j] = ((const f32x4*)P.fng)[lane + 64 * j];
    for (int m = gw; m < M; m += NGW) { f32x4* xr = (f32x4*)(P.out + (size_t)m * D) + lane;
        const float rs = __builtin_amdgcn_rsqf(ssq2[m] * (1.0f / 1024.0f) + 1e-6f);
#pragma unroll
        for (int j = 0; j < 4; ++j) { const f32x4 v = xr[64 * j]; xr[64 * j] = v * rs * g[j]; } }
}

#define XB_TMO      128
#define XB_XCNT(j)  (256  + 64 * (j))
#define XB_XSUB(j)  (1280 + 64 * (j))
#define XB_XGEN(j)  (2304 + 64 * (j))
#define XB_TOP      3328
#define XB_TOPGEN   3392
#define XCD_BAR_WORDS 3456
#define XB_SPIN_CAP (1u << 18)

__device__ __forceinline__ unsigned xb_ld(unsigned* p)              { return __hip_atomic_load(p, __ATOMIC_RELAXED, __HIP_MEMORY_SCOPE_AGENT); }
__device__ __forceinline__ unsigned xb_add(unsigned* p, unsigned v) { return __hip_atomic_fetch_add(p, v, __ATOMIC_RELAXED, __HIP_MEMORY_SCOPE_AGENT); }
__device__ __forceinline__ unsigned xb_xcc_id() { return (unsigned)__builtin_amdgcn_s_getreg((3 << 11) | 20) & 0xFu; }
#define XB_SPIN(cond, bar) do { unsigned _sp = 0; while (cond) { __builtin_amdgcn_s_sleep(1); \
    if ((++_sp & 255u) == 0u) { if (xb_ld(&(bar)[XB_TMO])) break; if (_sp > XB_SPIN_CAP) { atomicAdd(&(bar)[XB_TMO], 1u); break; } } } } while (0)

struct XcdBarrier {
    unsigned* bar; unsigned x;
    volatile LAS unsigned* st;
};

__device__ __forceinline__ XcdBarrier xcd_barrier_post(unsigned* bar, volatile LAS unsigned* st) {
    XcdBarrier b; b.bar = bar; b.x = xb_xcc_id(); b.st = st;
    if (threadIdx.x == 0) (void)xb_add(&bar[XB_XCNT(b.x)], 1u);
    return b;
}
__device__ __forceinline__ void xcd_barrier_complete(unsigned* bar, unsigned x, unsigned& nloc, unsigned& nx) {
    const unsigned G = gridDim.x * gridDim.y * gridDim.z;
    unsigned sum, cnt, mine, sp = 0u;
    for (;;) {
        sum = 0u; cnt = 0u; mine = 0u;
#pragma unroll
        for (unsigned j = 0; j < 16; ++j) { const unsigned c = xb_ld(&bar[XB_XCNT(j)]); sum += c; cnt += (c > 0u) ? 1u : 0u; mine = (j == x) ? c : mine; }
        if (sum == G) break;
        __builtin_amdgcn_s_sleep(1);
        if ((++sp & 255u) == 0u) { if (xb_ld(&bar[XB_TMO])) break; if (sp > XB_SPIN_CAP) { atomicAdd(&bar[XB_TMO], 1u); break; } }
    }
    nloc = mine > 0u ? mine : 1u; nx = cnt > 0u ? cnt : 1u;
}

__device__ __forceinline__ void xcd_barrier(const XcdBarrier& b) {
    asm volatile("s_waitcnt vmcnt(0)" ::: "memory");
    __syncthreads();
    if (threadIdx.x == 0) {
        unsigned* bar = b.bar;
        __builtin_amdgcn_s_waitcnt(0);
        unsigned nloc = b.st[0], nx = b.st[1];
        if (nloc == 0u) { xcd_barrier_complete(bar, b.x, nloc, nx); b.st[0] = nloc; b.st[1] = nx; }
        const unsigned old = xb_add(&bar[XB_XSUB(b.x)], 1u);
        const unsigned gen = old / nloc;
        if (old + 1u == (gen + 1u) * nloc) {
            __builtin_amdgcn_fence(__ATOMIC_RELEASE, "agent");
            asm volatile("s_waitcnt vmcnt(0)" ::: "memory");
            const unsigned og = xb_add(&bar[XB_TOP], 1u);
            const unsigned tg = og / nx;
            if (og + 1u == (tg + 1u) * nx) xb_add(&bar[XB_TOPGEN], 1u);
            else XB_SPIN(xb_ld(&bar[XB_TOPGEN]) == tg, bar);
            __builtin_amdgcn_fence(__ATOMIC_ACQUIRE, "agent");
            xb_add(&bar[XB_XGEN(b.x)], 1u);
            asm volatile("s_waitcnt vmcnt(0)" ::: "memory");
        } else {
            XB_SPIN(xb_ld(&bar[XB_XGEN(b.x)]) == gen, bar);
            __builtin_amdgcn_fence(__ATOMIC_ACQUIRE, "agent");
            asm volatile("s_waitcnt vmcnt(0)" ::: "memory");
        }
    }
    __syncthreads();
}

struct Args { Ptrs p; int ph_lo, ph_hi, cg_seam0, pad; };
__global__ void __launch_bounds__(NT, 2) trunk_fwd(Args args) {
    extern __shared__ __attribute__((aligned(16))) unsigned char lds_raw[];
    LAS unsigned char* lds = (LAS unsigned char*)lds_raw;
    cg::grid_group grid = cg::this_grid();
    const Ptrs& P = args.p;
    const int tid = threadIdx.x, lane = tid & 63, wave = __builtin_amdgcn_readfirstlane(tid >> 6);
    const int G = gridDim.x, gw = blockIdx.x * NWAVES + wave, NGW = G * NWAVES, gtid = blockIdx.x * NT + tid, GT = G * NT;
    const int lo = args.ph_lo, hi = args.ph_hi;
#define IN(k) (lo <= (k) && (k) < hi)
    if (tid < 8) ((volatile LAS unsigned*)(lds + 131072))[tid] = 0u;
    __syncthreads();
    XcdBarrier bar = xcd_barrier_post((unsigned*)P.ws, (volatile LAS unsigned*)(lds + 131072));
#define SEAM(k) do { if (IN(k) && IN((k) + 1)) { if ((k) == 0 && args.cg_seam0) grid.sync(); else xcd_barrier(bar); } } while (0)
    unsigned char* ws = P.ws;
    const bool split_p0 = (G == 256) && IN(0) && IN(1);
    if (IN(0)) { p0_prologue(P, lds, gw, NGW, wave, lane, gtid, GT, split_p0 ? 1 : 0); __syncthreads(); }
    SEAM(0);
    if (IN(1)) {
        pg8::Gemm g{(const bf16*)(ws + WS_XB), (const bf16*)(ws + WS_W0T), M, NIN0, D}; pg8::StaticOrder S; S.init(M, NIN0, G, (int)blockIdx.x);
        pg8::EpiLruIn E{(bf16*)(ws + WS_U0), (const float*)(ws + WS_SSQ0)};
        pg8::gemm_phase<pg8::EpiLruIn, pg8::StaticOrder, true, true>(lds, g, S, E);
        if (split_p0 && blockIdx.x >= 128) { __syncthreads(); p0_prologue(P, lds, (blockIdx.x - 128) * NWAVES + wave, 128 * NWAVES, wave, lane, 0, 1, 2); __syncthreads(); }
    }
    SEAM(1);
    if (IN(2)) lru_phase(P, lds, G, wave, lane, tid);
    if (IN(2) && IN(4)) xcd_barrier(bar);
    if (IN(4)) {
        pg8::Gemm g{(const bf16*)(ws + WS_YG), (const bf16*)(ws + WS_WO0T), M, D, LW}; pg8::StaticOrder S; S.init(M, D, G, (int)blockIdx.x);
        pg8::EpiResidB E{(const bf16*)(ws + WS_XB), (bf16*)(ws + WS_XB), (float*)(ws + WS_SSQ1), D};
        pg8::gemm_phase<pg8::EpiResidB, pg8::StaticOrder, false, true>(lds, g, S, E);
    }
    SEAM(4);
    if (IN(5)) {
        { pg8::Gemm g{(const bf16*)(ws + WS_XB), (const bf16*)(ws + WS_W1T), M, NQKG, D}; pg8::StaticOrder S; S.init(M, NQKG, G, (int)blockIdx.x);
          pg8::EpiQKG E{(bf16*)(ws + WS_U1), (const float*)(ws + WS_SSQ1), QSCALE};
          pg8::gemm_phase<pg8::EpiQKG, pg8::StaticOrder, true, true>(lds, g, S, E); }
        { pg8::Gemm g{(const bf16*)(ws + WS_W1T) + (size_t)NQKG * D, (const bf16*)(ws + WS_XB), AW, M, D}; pg8::StaticOrder S; S.init(AW, M, G, (int)blockIdx.x);
          pg8::EpiVF E{(bf16*)(ws + WS_VT), (const float*)(ws + WS_SSQ1)};
          pg8::gemm_phase<pg8::EpiVF, pg8::StaticOrder, false, true>(lds, g, S, E); }
    }
    SEAM(5);
    if (IN(6)) attn_phase(P, gw, NGW, lane);
    SEAM(6);
    if (IN(7)) {
        pg8::Gemm g{(const bf16*)(ws + WS_OG), (const bf16*)(ws + WS_WO1T), M, D, AW}; pg8::StaticOrder S; S.init(M, D, G, (int)blockIdx.x);
        if (G == 256) {
            pg8::EpiResidNorm E{(const bf16*)(ws + WS_XB), P.out, P.fng, (unsigned long long*)(ws + WS_X), D};
            pg8::gemm_phase<pg8::EpiResidNorm, pg8::StaticOrder, false, true>(lds, g, S, E);
        } else {
            pg8::EpiResid<true, true, false> E{(const void*)(ws + WS_XB), P.out, nullptr, (float*)(ws + WS_SSQ2), D};
            pg8::gemm_phase<pg8::EpiResid<true, true, false>, pg8::StaticOrder, false, true>(lds, g, S, E);
            xcd_barrier(bar);
            final_norm(P, gw, NGW, lane);
        }
    }
#undef IN
#undef SEAM
}

extern "C" void kernel_launch(void* const* d_in, const int* in_sizes, int n_in, void* d_out, int out_size, void* d_ws, size_t ws_size, hipStream_t stream) {
    static int grid = 0;
    if (grid == 0) {
        if (n_in != 12 || in_sizes[0] != M * D || out_size != M * D || ws_size < WS_END) { fprintf(stderr, "kernel_launch: unexpected shapes (n_in %d, in0 %d, out %d, ws %zu)\n", n_in, n_in > 0 ? in_sizes[0] : -1, out_size, ws_size); grid = -1; return; }
        int dev = 0, cus = 0, per_cu = 0;
        hipGetDevice(&dev); hipDeviceGetAttribute(&cus, hipDeviceAttributeMultiprocessorCount, dev);
        hipFuncSetAttribute((const void*)trunk_fwd, hipFuncAttributeMaxDynamicSharedMemorySize, LDS_BYTES);
        hipOccupancyMaxActiveBlocksPerMultiprocessor(&per_cu, (const void*)trunk_fwd, NT, LDS_BYTES);
        if (per_cu < 1) { fprintf(stderr, "kernel_launch: occupancy query reports %d workgroups per CU\n", per_cu); per_cu = 1; }
        (void)hipGetLastError();
        grid = (cus / 64) * 64;
        fprintf(stderr, "kernel_launch: grid %d (cus %d, per_cu %d)\n", grid, cus, per_cu);
    }
    if (grid < 0) return;
    Args a{};
    a.p.x = (const float*)d_in[0]; a.p.norm_g = (const float*)d_in[1]; a.p.fng = (const float*)d_in[2]; a.p.lwin = (const float*)d_in[3];
    a.p.lcw = (const float*)d_in[4]; a.p.lcb = (const float*)d_in[5]; a.p.lwg = (const float*)d_in[6]; a.p.lbg = (const float*)d_in[7];
    a.p.llam = (const float*)d_in[8]; a.p.lwout = (const float*)d_in[9]; a.p.swin = (const float*)d_in[10]; a.p.swout = (const float*)d_in[11];
    a.p.out = (float*)d_out; a.p.ws = (unsigned char*)d_ws;
    a.ph_lo = 0; a.ph_hi = 9; a.cg_seam0 = 0;
    if (hipMemsetAsync(d_ws, 0, 16384, stream) != hipSuccess) { fprintf(stderr, "kernel_launch: memset of the barrier words failed\n"); return; }
    void* kargs[] = {&a};
    hipError_t e = hipLaunchCooperativeKernel((const void*)trunk_fwd, dim3(grid), dim3(NT), kargs, LDS_BYTES, stream);
    if (e != hipSuccess) fprintf(stderr, "cooperative launch failed: %s (grid %d)\n", hipGetErrorString(e), grid);
}
```

```cpp
#include <hip/hip_runtime.h>
#include <hip/hip_cooperative_groups.h>
#include <cstdio>
#include <cstdint>
namespace cg = cooperative_groups;
namespace pg8 {
#define PG8_LAS __attribute__((address_space(3)))
typedef unsigned short bf16_t;
typedef short bf16x8 __attribute__((ext_vector_type(8)));
typedef float f32x4 __attribute__((ext_vector_type(4)));
typedef unsigned u32x4 __attribute__((ext_vector_type(4)));
constexpr int BM = 256, BK = 64, HALF = 128, HTB = HALF * BK * 2  , STAGE_BYTES = 8 * HTB, NXCD = 8, WGM = 8;

__host__ __device__ __forceinline__ int lds_byte(int r, int c) { const int st = (r >> 4) * 2 + (c >> 5), rr = r & 15, cc = c & 31, ob = rr * 64 + cc * 2; return st * 1024 + (ob ^ (((ob >> 9) & 1) << 5)); }
__host__ __device__ __forceinline__ void stage_rc(int b, int& R, int& C) { const int st = b / 1024, sb = b % 1024, swz = sb ^ (((sb >> 9) & 1) << 5); R = (st >> 1) * 16 + swz / 64; C = (st & 1) * 32 + (swz % 64) / 2; }
__host__ __device__ __forceinline__ int perm32(int rho) { const int n = rho >> 4, i = rho & 15; return 8 * (i >> 2) + 4 * n + (i & 3); }

struct Unit { int pm, pn; };
struct Gemm { const bf16_t* A; const bf16_t* Bt; int M, N, K; };

struct StaticOrder {
    int nM, nN, nwg, G, c;
    __host__ __device__ void init(int M, int N, int G_, int c_) { nM = M / BM; nN = N / BM; nwg = nM * nN; G = G_; c = c_; }
    __host__ __device__ bool next(int i, Unit& u) const {
        const long L = (long)i * G + c; if (L >= nwg) return false;
        int wgid = (int)L; { const int q = nwg / NXCD, r = nwg % NXCD, xcd = wgid % NXCD, off = wgid / NXCD; wgid = (xcd < r ? xcd * (q + 1) : r * (q + 1) + (xcd - r) * q) + off; }
        const int nig = WGM * nN, gid = wgid / nig, fm = gid * WGM, gsz = (nM - fm) < WGM ? (nM - fm) : WGM;
        u.pm = fm + ((wgid % nig) % gsz); u.pn = (wgid % nig) / gsz; return true;
    }
    __device__ __forceinline__ void a_ready(const Unit&) const {}
    __device__ __forceinline__ void done(const Unit&) const {}
};

__device__ __forceinline__ unsigned cvt_pk_bf16(float lo, float hi) { unsigned r; asm volatile("v_cvt_pk_bf16_f32 %0, %1, %2" : "=v"(r) : "v"(lo), "v"(hi)); return r; }
typedef float f32x2 __attribute__((ext_vector_type(2)));
struct EpiResidNorm {
    static constexpr bool PERM = false, AFTER_DRAIN = true;
    const bf16_t* base; float* out; const float* gain; unsigned long long* slots; int ldc;
    __device__ __forceinline__ void fused(f32x4 (&acc)[2][2][4][2], const Unit& u, int wr, int wc, int fr, int fq, PG8_LAS unsigned char* lds, int wid, int lane) const {
        PG8_LAS float* Pp = (PG8_LAS float*)lds; PG8_LAS float* S = (PG8_LAS float*)(lds + 4096);
        const int col0 = u.pn * BM + wc * 32 + 4 * fq;
        unsigned long long rb[2][4][2][2];
#pragma unroll
        for (int ai = 0; ai < 2; ++ai)
#pragma unroll
            for (int m = 0; m < 4; ++m)
#pragma unroll
                for (int bj = 0; bj < 2; ++bj)
#pragma unroll
                    for (int n = 0; n < 2; ++n) rb[ai][m][bj][n] = *(const unsigned long long*)(base + (size_t)(u.pm * BM + ai * HALF + wr * 64 + m * 16 + fr) * ldc + col0 + bj * HALF + n * 16);
        asm volatile("" ::: "memory");
#pragma unroll
        for (int ai = 0; ai < 2; ++ai)
#pragma unroll
            for (int m = 0; m < 4; ++m) { const int rl = ai * HALF + wr * 64 + m * 16 + fr; float s = 0.f;
#pragma unroll
                for (int bj = 0; bj < 2; ++bj)
#pragma unroll
                    for (int n = 0; n < 2; ++n) { const unsigned long long rw = rb[ai][m][bj][n]; const unsigned lo = (unsigned)rw, hi = (unsigned)(rw >> 32);
                        const f32x4 bs = {__uint_as_float(lo << 16), __uint_as_float(lo & 0xffff0000u), __uint_as_float(hi << 16), __uint_as_float(hi & 0xffff0000u)};
                        const f32x4 v = bs + acc[ai][bj][m][n]; acc[ai][bj][m][n] = v;
                        s += (v[0] * v[0] + v[1] * v[1]) + (v[2] * v[2] + v[3] * v[3]); }
                s += __shfl_xor(s, 16); s += __shfl_xor(s, 32);
                if (fq == 0) Pp[rl * 4 + wc] = s;
                asm volatile("" ::: "memory"); }
        asm volatile("s_waitcnt lgkmcnt(0)" ::: "memory"); __builtin_amdgcn_s_barrier(); asm volatile("" ::: "memory");
        const int tid = wid * 64 + lane;
        if (tid < 256) { const f32x4 p = *(const PG8_LAS f32x4*)(Pp + tid * 4); const float mine = (p[0] + p[1]) + (p[2] + p[3]);
            unsigned long long* sl = slots + (size_t)(u.pm * BM + tid) * 4;
            __hip_atomic_store(sl + u.pn, (1ull << 32) | (unsigned long long)__float_as_uint(mine), __ATOMIC_RELAXED, __HIP_MEMORY_SCOPE_AGENT);
            float tot = 0.f;
#pragma unroll
            for (int t = 0; t < 4; ++t) { float val = mine;
                if (t != u.pn) { unsigned long long v; unsigned sp = 0;
                    for (;;) { v = __hip_atomic_load(sl + t, __ATOMIC_RELAXED, __HIP_MEMORY_SCOPE_AGENT); if ((unsigned)(v >> 32) == 1u || ++sp > (1u << 22)) break; __builtin_amdgcn_s_sleep(1); }
                    val = __uint_as_float((unsigned)v); }
                tot += val; }
            S[tid] = __builtin_amdgcn_rsqf(tot * (1.0f / 1024.0f) + 1e-6f); }
        asm volatile("s_waitcnt lgkmcnt(0)" ::: "memory"); __builtin_amdgcn_s_barrier(); asm volatile("" ::: "memory");
        f32x4 gv[2][2];
#pragma unroll
        for (int bj = 0; bj < 2; ++bj)
#pragma unroll
            for (int n = 0; n < 2; ++n) gv[bj][n] = *(const f32x4*)(gain + col0 + bj * HALF + n * 16);
#pragma unroll
        for (int ai = 0; ai < 2; ++ai)
#pragma unroll
            for (int m = 0; m < 4; ++m) { const int rl = ai * HALF + wr * 64 + m * 16 + fr; const float rs = S[rl]; const size_t off = (size_t)(u.pm * BM + rl) * ldc + col0;
#pragma unroll
                for (int bj = 0; bj < 2; ++bj)
#pragma unroll
                    for (int n = 0; n < 2; ++n) *(f32x4*)(out + off + bj * HALF + n * 16) = acc[ai][bj][m][n] * rs * gv[bj][n];
                asm volatile("" ::: "memory"); }
    }
};
struct EpiLruIn {
    static constexpr bool PERM = true, AFTER_DRAIN = false;
    bf16_t* XF; const float* ssq;
    __device__ __forceinline__ void operator()(const f32x4 (&acc)[2][2][4][2], const Unit& u, int wr, int wc, int fr, int fq) const {
        const int row0 = u.pm * BM + wr * 64 + fr, colt = u.pn * BM, part = colt >= 1280 ? 1 : 0;
        bf16_t* base = XF + (size_t)part * ((size_t)16384 * 1280);
#pragma unroll
        for (int ai = 0; ai < 2; ++ai)
#pragma unroll
            for (int m = 0; m < 4; ++m) { const int row = row0 + ai * HALF + m * 16;
                const float rs = __builtin_amdgcn_rsqf(ssq[row] * (1.0f / 1024.0f) + 1e-6f);
                const int b = row >> 12, tl = row & 4095, tile = tl >> 5, r = tl & 31;
#pragma unroll
                for (int bj = 0; bj < 2; ++bj) { const int cc = colt - part * 1280 + bj * HALF + wc * 32 + 8 * fq, hd = cc / 80, ch8 = cc - hd * 80;
                    const f32x4 v0 = acc[ai][bj][m][0] * rs, v1 = acc[ai][bj][m][1] * rs;
                    bf16_t* p = base + ((size_t)((((b * 128 + tile) * 16 + hd) * 10 + (ch8 >> 3)) * 64 + r) << 2);
                    *(unsigned long long*)p = (unsigned long long)cvt_pk_bf16(v0[0], v0[1]) | ((unsigned long long)cvt_pk_bf16(v0[2], v0[3]) << 32);
                    *(unsigned long long*)(p + 128) = (unsigned long long)cvt_pk_bf16(v1[0], v1[1]) | ((unsigned long long)cvt_pk_bf16(v1[2], v1[3]) << 32); }
                asm volatile("" ::: "memory"); }
    }
};
struct EpiQKG {
    static constexpr bool PERM = true, AFTER_DRAIN = false;
    bf16_t* QF; const float* ssq; float qscale;
    __device__ __forceinline__ void operator()(const f32x4 (&acc)[2][2][4][2], const Unit& u, int wr, int wc, int fr, int fq) const {
        const int row0 = u.pm * BM + wr * 64 + fr, colt = u.pn * BM, region = colt >> 10;
        const float sc = (region == 0) ? qscale : 1.f;
        bf16_t* base = QF + (size_t)region * ((size_t)16384 * 1024);
#pragma unroll
        for (int ai = 0; ai < 2; ++ai)
#pragma unroll
            for (int m = 0; m < 4; ++m) { const int row = row0 + ai * HALF + m * 16;
                const float rs = __builtin_amdgcn_rsqf(ssq[row] * (1.0f / 1024.0f) + 1e-6f) * sc;
                const int b = row >> 12, tl = row & 4095, tile = tl >> 5, r = tl & 31;
#pragma unroll
                for (int bj = 0; bj < 2; ++bj) { const int cc = (colt & 1023) + bj * HALF + wc * 32 + 8 * fq, h = cc >> 6, d8 = cc & 63, bh = b * 16 + h;
                    const f32x4 v0 = acc[ai][bj][m][0] * rs, v1 = acc[ai][bj][m][1] * rs;
                    u32x4 w; w.x = cvt_pk_bf16(v0[0], v0[1]); w.y = cvt_pk_bf16(v0[2], v0[3]); w.z = cvt_pk_bf16(v1[0], v1[1]); w.w = cvt_pk_bf16(v1[2], v1[3]);
                    if (region < 2) { const int ks = d8 >> 4, hh = (d8 >> 3) & 1;
                        *(u32x4*)(base + ((size_t)(((bh * 128 + tile) * 4 + ks) * 64 + hh * 32 + r) << 3)) = w;
                    } else { const int dt = d8 >> 5, g = (d8 >> 3) & 3; bf16_t* p = base + ((size_t)((((bh * 128 + tile) * 2 + dt) * 4 + g) * 64 + r) << 2);
                        *(unsigned long long*)p = (unsigned long long)w.x | ((unsigned long long)w.y << 32);
                        *(unsigned long long*)(p + 128) = (unsigned long long)w.z | ((unsigned long long)w.w << 32); } }
                asm volatile("" ::: "memory"); }
    }
};
struct EpiVF {
    static constexpr bool PERM = true, AFTER_DRAIN = false;
    bf16_t* VF; const float* ssq;
    __device__ __forceinline__ void operator()(const f32x4 (&acc)[2][2][4][2], const Unit& u, int wr, int wc, int fr, int fq) const {
        const int row0 = u.pm * BM + wr * 64 + fr, col0 = u.pn * BM + wc * 32 + 8 * fq;
        f32x4 cs[2][2];
#pragma unroll
        for (int bj = 0; bj < 2; ++bj)
#pragma unroll
            for (int n = 0; n < 2; ++n) { const f32x4 q = *(const f32x4*)(ssq + col0 + bj * HALF + 4 * n);
#pragma unroll
                for (int e = 0; e < 4; ++e) cs[bj][n][e] = __builtin_amdgcn_rsqf(q[e] * (1.0f / 1024.0f) + 1e-6f); }
#pragma unroll
        for (int ai = 0; ai < 2; ++ai)
#pragma unroll
            for (int m = 0; m < 4; ++m) { const int row = row0 + ai * HALF + m * 16, h = row >> 6, d = row & 63, dt = d >> 5, r = d & 31;
#pragma unroll
                for (int bj = 0; bj < 2; ++bj) { const int col = col0 + bj * HALF, b = col >> 12, tl = col & 4095, kt = tl >> 5, k0 = tl & 31, s = k0 >> 4, half = (k0 >> 3) & 1, bh = b * 16 + h;
                    const f32x4 v0 = acc[ai][bj][m][0] * cs[bj][0], v1 = acc[ai][bj][m][1] * cs[bj][1];
                    bf16_t* p = VF + (((size_t)((((bh * 128 + kt) * 2 + dt) * 2 + s) * 64 + r)) << 3) + 4 * half;
                    *(unsigned long long*)p = (unsigned long long)cvt_pk_bf16(v0[0], v0[1]) | ((unsigned long long)cvt_pk_bf16(v0[2], v0[3]) << 32);
                    *(unsigned long long*)(p + 256) = (unsigned long long)cvt_pk_bf16(v1[0], v1[1]) | ((unsigned long long)cvt_pk_bf16(v1[2], v1[3]) << 32); }
                asm volatile("" ::: "memory"); }
    }
};
struct EpiResidB {
    static constexpr bool PERM = true, AFTER_DRAIN = false;
    const bf16_t* base; bf16_t* outb; float* ssq; int ldc;
    __device__ __forceinline__ void operator()(const f32x4 (&acc)[2][2][4][2], const Unit& u, int wr, int wc, int fr, int fq) const {
        const int row0 = u.pm * BM + wr * 64 + fr, col0 = u.pn * BM + wc * 32 + 8 * fq;
        u32x4 rb[2][4][2];
#pragma unroll
        for (int ai = 0; ai < 2; ++ai)
#pragma unroll
            for (int m = 0; m < 4; ++m)
#pragma unroll
                for (int bj = 0; bj < 2; ++bj) rb[ai][m][bj] = *(const u32x4*)(base + (size_t)(row0 + ai * HALF + m * 16) * ldc + col0 + bj * HALF);
        asm volatile("" ::: "memory");
#pragma unroll
        for (int ai = 0; ai < 2; ++ai)
#pragma unroll
            for (int m = 0; m < 4; ++m) { const int row = row0 + ai * HALF + m * 16; float s = 0.f;
#pragma unroll
                for (int bj = 0; bj < 2; ++bj) { const u32x4 w = rb[ai][m][bj];
                    const f32x4 v0 = acc[ai][bj][m][0] + (f32x4){__uint_as_float(w.x << 16), __uint_as_float(w.x & 0xffff0000u), __uint_as_float(w.y << 16), __uint_as_float(w.y & 0xffff0000u)};
                    const f32x4 v1 = acc[ai][bj][m][1] + (f32x4){__uint_as_float(w.z << 16), __uint_as_float(w.z & 0xffff0000u), __uint_as_float(w.w << 16), __uint_as_float(w.w & 0xffff0000u)};
                    s += ((v0[0] * v0[0] + v0[1] * v0[1]) + (v0[2] * v0[2] + v0[3] * v0[3])) + ((v1[0] * v1[0] + v1[1] * v1[1]) + (v1[2] * v1[2] + v1[3] * v1[3]));
                    u32x4 o; o.x = cvt_pk_bf16(v0[0], v0[1]); o.y = cvt_pk_bf16(v0[2], v0[3]); o.z = cvt_pk_bf16(v1[0], v1[1]); o.w = cvt_pk_bf16(v1[2], v1[3]);
                    *(u32x4*)(outb + (size_t)row * ldc + col0 + bj * HALF) = o; }
                s += __shfl_xor(s, 16); s += __shfl_xor(s, 32);
                if (fq == 0) atomicAdd(ssq + row, s); }
    }
};
template <bool BB, bool WF, bool WB> struct EpiResid {
    static constexpr bool PERM = false, AFTER_DRAIN = false;
    const void* base; float* out; bf16_t* outb; float* ssq; int ldc;
    __device__ __forceinline__ void operator()(const f32x4 (&acc)[2][2][4][2], const Unit& u, int wr, int wc, int fr, int fq) const {
        const int row0 = u.pm * BM + wr * 64 + fr, col0 = u.pn * BM + wc * 32 + 4 * fq;
        unsigned long long rb[2][4][2][2];
        if (BB) {
#pragma unroll
            for (int ai = 0; ai < 2; ++ai)
#pragma unroll
                for (int m = 0; m < 4; ++m)
#pragma unroll
                    for (int bj = 0; bj < 2; ++bj)
#pragma unroll
                        for (int n = 0; n < 2; ++n) rb[ai][m][bj][n] = *(const unsigned long long*)((const bf16_t*)base + (size_t)(row0 + ai * HALF + m * 16) * ldc + col0 + bj * HALF + n * 16);
            asm volatile("" ::: "memory"); }
#pragma unroll
        for (int ai = 0; ai < 2; ++ai)
#pragma unroll
            for (int m = 0; m < 4; ++m) { const int row = row0 + ai * HALF + m * 16; const size_t off = (size_t)row * ldc + col0; float s = 0.f;
#pragma unroll
                for (int bj = 0; bj < 2; ++bj)
#pragma unroll
                    for (int n = 0; n < 2; ++n) { f32x4 bs;
                        if (BB) { const unsigned long long rw = rb[ai][m][bj][n]; const unsigned lo = (unsigned)rw, hi = (unsigned)(rw >> 32);
                            bs = (f32x4){__uint_as_float(lo << 16), __uint_as_float(lo & 0xffff0000u), __uint_as_float(hi << 16), __uint_as_float(hi & 0xffff0000u)}; }
                        else bs = *(const f32x4*)((const float*)base + off + bj * HALF + n * 16);
                        const f32x4 v = bs + acc[ai][bj][m][n];
                        if (WF) *(f32x4*)(out + off + bj * HALF + n * 16) = v;
                        s += (v[0] * v[0] + v[1] * v[1]) + (v[2] * v[2] + v[3] * v[3]);
                        if (WB) { unsigned lo = cvt_pk_bf16(v[0], v[1]), hi = cvt_pk_bf16(v[2], v[3]); *(unsigned long long*)(outb + off + bj * HALF + n * 16) = (unsigned long long)lo | ((unsigned long long)hi << 32); } }
                s += __shfl_xor(s, 16); s += __shfl_xor(s, 32);
                if (fq == 0) atomicAdd(ssq + row, s);
                asm volatile("" ::: "memory"); }
    }
};
template <class Epi, class Sched, bool ALIGN_EPI = false, bool SP2 = false>
__device__ __forceinline__ void gemm_phase(PG8_LAS unsigned char* lds, const Gemm g, const Sched& S, const Epi& E) {
    const int tid = threadIdx.x, wid = __builtin_amdgcn_readfirstlane(tid >> 6), lane = tid & 63, wr = wid >> 2, wc = wid & 3, fr = lane & 15, fq = lane >> 4;
    const int K = g.K, nt = K / BK;
    unsigned voffA[2], voffB[2];
#pragma unroll
    for (int i = 0; i < 2; ++i) { int R, C; stage_rc(tid * 16 + i * 8192, R, C); const int Rb = Epi::PERM ? ((R & ~31) + perm32(R & 31)) : R;
        voffA[i] = (unsigned)(R * K + C) * 2u; voffB[i] = (unsigned)(Rb * K + C) * 2u; }
    const size_t kstep = (size_t)(BK * 2);
    const size_t hstep = (size_t)HALF * K * 2;
    const size_t tstep = 2 * hstep;
    const unsigned ldsw = (unsigned)wid * 1024u;
    const int aoff = lds_byte(wr * 64 + fr, fq * 8), boff = lds_byte(wc * 32 + fr, fq * 8);
#define PG8_SA(b, h) (((b) * 2 + (h)) * HTB)
#define PG8_SB(b, h) ((4 + (b) * 2 + (h)) * HTB)
#define PG8_STAGE(bufoff, gbase, voff) do { _Pragma("unroll") for (int _i = 0; _i < 2; ++_i) \
        __builtin_amdgcn_global_load_lds((const unsigned*)((const char*)(gbase) + (voff)[_i]), (PG8_LAS unsigned*)(lds + (bufoff) + ldsw + _i * 8192), 16, 0, 0); } while (0)
#define PG8_LDA(dst, b, h) do { _Pragma("unroll") for (int m = 0; m < 4; ++m) _Pragma("unroll") for (int k = 0; k < 2; ++k) dst[m][k] = *(const PG8_LAS bf16x8*)(lds + PG8_SA(b, h) + aoff + m * 2048 + k * 1024); } while (0)
#define PG8_LDB(dst, b, h) do { _Pragma("unroll") for (int n = 0; n < 2; ++n) _Pragma("unroll") for (int k = 0; k < 2; ++k) dst[n][k] = *(const PG8_LAS bf16x8*)(lds + PG8_SB(b, h) + boff + n * 2048 + k * 1024); } while (0)
#define PG8_MMA(ai, bj, At, Bt) do { __builtin_amdgcn_s_setprio(1); _Pragma("unroll") for (int m = 0; m < 4; ++m) _Pragma("unroll") for (int n = 0; n < 2; ++n) _Pragma("unroll") for (int k = 0; k < 2; ++k) \
        acc[ai][bj][m][n] = __builtin_amdgcn_mfma_f32_16x16x32_bf16(Bt[n][k], At[m][k], acc[ai][bj][m][n], 0, 0, 0); __builtin_amdgcn_s_setprio(0); } while (0)
#define PG8_WAIT_V(n) asm volatile("s_waitcnt vmcnt(" #n ")" ::: "memory")
#define PG8_WAIT_L(n) asm volatile("s_waitcnt lgkmcnt(" #n ")" ::: "memory")
#define PG8_BAR __builtin_amdgcn_s_barrier()
#define PG8_SCHED __builtin_amdgcn_sched_barrier(0)
    Unit cur, nxt; int ui = 0;
    if (!S.next(0, cur)) return;
    f32x4 acc[2][2][4][2];
#pragma unroll
    for (int a = 0; a < 2; ++a)
#pragma unroll
        for (int b = 0; b < 2; ++b)
#pragma unroll
            for (int m = 0; m < 4; ++m)
#pragma unroll
                for (int n = 0; n < 2; ++n) acc[a][b][m][n] = (f32x4){0.f, 0.f, 0.f, 0.f};
    bf16x8 At[4][2], B0[2][2], B1[2][2];
    const char* cA = (const char*)g.A + (size_t)cur.pm * tstep; const char* cB = (const char*)g.Bt + (size_t)cur.pn * tstep;
    S.a_ready(cur);
    if constexpr (SP2) {
        PG8_STAGE(PG8_SB(0, 0), cB, voffB); PG8_STAGE(PG8_SB(0, 1), cB + hstep, voffB); PG8_STAGE(PG8_SA(0, 0), cA, voffA); PG8_STAGE(PG8_SA(0, 1), cA + hstep, voffA);
        if (wr == 1) PG8_BAR;
        PG8_WAIT_V(2); PG8_BAR;
        PG8_STAGE(PG8_SB(1, 0), cB + kstep, voffB); PG8_STAGE(PG8_SA(1, 0), cA + kstep, voffA); PG8_STAGE(PG8_SB(1, 1), cB + hstep + kstep, voffB);
        PG8_WAIT_V(6); PG8_BAR;
    } else {
        PG8_STAGE(PG8_SB(0, 0), cB, voffB); PG8_STAGE(PG8_SA(0, 0), cA, voffA); PG8_STAGE(PG8_SB(0, 1), cB + hstep, voffB); PG8_STAGE(PG8_SA(0, 1), cA + hstep, voffA);
        if (wr == 1) PG8_BAR;
        PG8_WAIT_V(4); PG8_BAR;
        PG8_STAGE(PG8_SB(1, 0), cB + kstep, voffB); PG8_STAGE(PG8_SA(1, 0), cA + kstep, voffA); PG8_STAGE(PG8_SB(1, 1), cB + hstep + kstep, voffB);
        PG8_WAIT_V(6); PG8_BAR;
    }
    for (;;) {
        const bool has_next = S.next(ui + 1, nxt);
        const char* nA = has_next ? (const char*)g.A + (size_t)nxt.pm * tstep : cA; const char* nB = has_next ? (const char*)g.Bt + (size_t)nxt.pn * tstep : cB;
        for (int t = 0; t < nt; t += 2) {
            const bool last = (t == nt - 2);
            const char* a1 = cA + (size_t)(t + 1) * kstep;
            const char* a2 = last ? nA : cA + (size_t)(t + 2) * kstep; const char* b2 = last ? nB : cB + (size_t)(t + 2) * kstep;
            const char* a3 = a2 + kstep; const char* b3 = b2 + kstep;
            if (last && has_next) S.a_ready(nxt);
            if constexpr (SP2) {
            PG8_LDB(B0, 0, 0); PG8_LDB(B1, 0, 1); PG8_SCHED; PG8_LDA(At, 0, 0); PG8_STAGE(PG8_SA(1, 1), a1 + hstep, voffA);
            PG8_WAIT_V(8); PG8_WAIT_L(0); PG8_BAR; PG8_MMA(0, 0, At, B0); PG8_MMA(0, 1, At, B1); PG8_BAR; PG8_SCHED;
            PG8_LDA(At, 0, 1); PG8_STAGE(PG8_SB(0, 0), b2, voffB); PG8_STAGE(PG8_SB(0, 1), b2 + hstep, voffB); PG8_STAGE(PG8_SA(0, 0), a2, voffA);
            PG8_WAIT_V(8); PG8_WAIT_L(0); PG8_BAR; PG8_MMA(1, 0, At, B0); PG8_MMA(1, 1, At, B1); PG8_BAR; PG8_SCHED;
            PG8_LDB(B0, 1, 0); PG8_LDB(B1, 1, 1); PG8_SCHED; PG8_LDA(At, 1, 0); PG8_STAGE(PG8_SA(0, 1), a2 + hstep, voffA);
            PG8_WAIT_V(8); PG8_WAIT_L(0); PG8_BAR; PG8_MMA(0, 0, At, B0); PG8_MMA(0, 1, At, B1); PG8_BAR; PG8_SCHED;
            PG8_LDA(At, 1, 1); PG8_STAGE(PG8_SB(1, 0), b3, voffB); PG8_STAGE(PG8_SB(1, 1), b3 + hstep, voffB); PG8_STAGE(PG8_SA(1, 0), a3, voffA);
            PG8_WAIT_V(8); PG8_WAIT_L(0); PG8_BAR; PG8_MMA(1, 0, At, B0); PG8_MMA(1, 1, At, B1); PG8_BAR; PG8_SCHED;
            } else {
            PG8_LDB(B0, 0, 0); PG8_SCHED; PG8_LDA(At, 0, 0); PG8_STAGE(PG8_SA(1, 1), a1 + hstep, voffA);
            PG8_WAIT_L(8); PG8_BAR; PG8_WAIT_L(0); PG8_MMA(0, 0, At, B0); PG8_BAR; PG8_SCHED;
            PG8_LDB(B1, 0, 1); PG8_STAGE(PG8_SB(0, 0), b2, voffB);
            PG8_BAR; PG8_WAIT_L(0); PG8_MMA(0, 1, At, B1); PG8_BAR;
            PG8_LDA(At, 0, 1); PG8_STAGE(PG8_SA(0, 0), a2, voffA);
            PG8_BAR; PG8_WAIT_L(0); PG8_MMA(1, 0, At, B0); PG8_BAR; PG8_SCHED;
            PG8_STAGE(PG8_SB(0, 1), b2 + hstep, voffB);
            PG8_WAIT_V(6); PG8_BAR; PG8_MMA(1, 1, At, B1); PG8_BAR;
            PG8_LDB(B0, 1, 0); PG8_SCHED; PG8_LDA(At, 1, 0); PG8_STAGE(PG8_SA(0, 1), a2 + hstep, voffA);
            PG8_WAIT_L(8); PG8_BAR; PG8_WAIT_L(0); PG8_MMA(0, 0, At, B0); PG8_BAR; PG8_SCHED;
            PG8_LDB(B1, 1, 1); PG8_STAGE(PG8_SB(1, 0), b3, voffB);
            PG8_BAR; PG8_WAIT_L(0); PG8_MMA(0, 1, At, B1); PG8_BAR;
            PG8_LDA(At, 1, 1); PG8_STAGE(PG8_SA(1, 0), a3, voffA);
            PG8_BAR; PG8_WAIT_L(0); PG8_MMA(1, 0, At, B0); PG8_BAR; PG8_SCHED;
            PG8_STAGE(PG8_SB(1, 1), b3 + hstep, voffB);
            PG8_WAIT_V(6); PG8_BAR; PG8_MMA(1, 1, At, B1); PG8_BAR;
            }
        }
        if constexpr (ALIGN_EPI) { if (wr == 0) PG8_BAR; }
        if constexpr (!Epi::AFTER_DRAIN) { E(acc, cur, wr, wc, fr, fq); S.done(cur); }
        if (!has_next) break;
#pragma unroll
        for (int a = 0; a < 2; ++a)
#pragma unroll
            for (int b = 0; b < 2; ++b)
#pragma unroll
                for (int m = 0; m < 4; ++m)
#pragma unroll
                    for (int n = 0; n < 2; ++n) acc[a][b][m][n] = (f32x4){0.f, 0.f, 0.f, 0.f};
        cur = nxt; cA = nA; cB = nB; ++ui;
        if constexpr (ALIGN_EPI) { if (wr == 1) PG8_BAR; }
    }
    PG8_WAIT_V(0);
    if constexpr (!ALIGN_EPI) { if (wr == 0) PG8_BAR; }
    PG8_BAR;
    if constexpr (Epi::AFTER_DRAIN) { E.fused(acc, cur, wr, wc, fr, fq, lds, wid, lane); S.done(cur); }
#undef PG8_SA
#undef PG8_SB
#undef PG8_STAGE
#undef PG8_LDA
#undef PG8_LDB
#undef PG8_MMA
#undef PG8_WAIT_V
#undef PG8_WAIT_L
#undef PG8_BAR
#undef PG8_SCHED
}
}
#define LAS __attribute__((address_space(3)))
typedef unsigned short bf16;
typedef unsigned v4u __attribute__((ext_vector_type(4)));
typedef unsigned v2u __attribute__((ext_vector_type(2)));
typedef float f32x4 __attribute__((ext_vector_type(4)));
typedef float f32x16 __attribute__((ext_vector_type(16)));
typedef short bf16x8 __attribute__((ext_vector_type(8)));
typedef float f32x2_t __attribute__((ext_vector_type(2))); typedef __bf16 bf16x2_t __attribute__((ext_vector_type(2)));
constexpr int NWAVES = 8, NT = 512;
constexpr int BATCH = 4, SEQ = 4096, D = 1024, M = BATCH * SEQ;
constexpr int LH = 16, LB = 80, LW = 1280;
constexpr int NIN0 = 2 * LW;
constexpr int AH = 16, HD = 64, AW = 1024, NIN1 = 4 * AW;
constexpr int NQKG = 3 * AW;
constexpr int CHUNK = 256, NCHUNK = SEQ / CHUNK;
constexpr float LOG2E = 1.4426950408889634f, LN2 = 0.6931471805599453f;
constexpr float QSCALE = 0.125f * LOG2E;
constexpr size_t MiB = 1u << 20;
constexpr size_t WS_SSQ0 = 1 * MiB, WS_SSQ1 = WS_SSQ0 + 65536, WS_SSQ2 = WS_SSQ1 + 65536, WS_SUM = WS_SSQ2 + 65536;
constexpr size_t WS_PAR = WS_SUM + 655360;
constexpr size_t WS_W0T = 2 * MiB, WS_WO0T = 8 * MiB, WS_W1T = 11 * MiB, WS_WO1T = 20 * MiB, WS_WGF = 22 * MiB;
constexpr size_t WS_X = 23 * MiB;
constexpr size_t WS_ZERO = WS_X + 524288;
constexpr size_t WS_XB = 24 * MiB;
constexpr size_t WS_U0 = 56 * MiB;
constexpr size_t WS_YG = 140 * MiB;
constexpr size_t WS_U1 = 56 * MiB;
constexpr size_t WS_VT = 156 * MiB;
constexpr size_t WS_OG = 188 * MiB;
constexpr size_t WS_END = 220 * MiB;
static_assert(WS_PAR + 40960 <= WS_W0T && WS_U0 + (size_t)M * NIN0 * 2 <= WS_YG && WS_YG + (size_t)M * LW * 2 <= WS_OG && WS_U1 + (size_t)M * NQKG * 2 <= WS_VT && WS_VT + (size_t)M * AW * 2 <= WS_OG, "ws map");
constexpr int LDS_BYTES = 135168;

__device__ __forceinline__ unsigned pk2(float lo, float hi) { f32x2_t v = {lo, hi}; bf16x2_t b = __builtin_convertvector(v, bf16x2_t); return __builtin_bit_cast(unsigned, b); }
__device__ __forceinline__ float bflo(unsigned u) { return __uint_as_float(u << 16); }
__device__ __forceinline__ float bfhi(unsigned u) { return __uint_as_float(u & 0xffff0000u); }
__device__ __forceinline__ float ex2(float x) { return __builtin_amdgcn_exp2f(x); }
__device__ __forceinline__ float rcpf_(float x) { return __builtin_amdgcn_rcpf(x); }
__device__ __forceinline__ float sigmoid_(float x) { return rcpf_(1.0f + ex2(-LOG2E * x)); }
__device__ __forceinline__ float wave_sum(float v) {
#pragma unroll
    for (int o = 1; o < 64; o <<= 1) v += __shfl_xor(v, o);
    return v;
}
#define LDS_WAIT() asm volatile("s_waitcnt lgkmcnt(0)" ::: "memory")
#define MFMA32(a, b, c) __builtin_amdgcn_mfma_f32_32x32x16_bf16((a), (b), (c), 0, 0, 0)
__device__ __forceinline__ int crow(int reg, int h) { return (reg & 3) + 8 * (reg >> 2) + 4 * h; }

__device__ __forceinline__ void p0_transpose_item(const float* W, int K, int N, bf16* WT, const float* ks, int radd, LAS float* scr, int kb, int nb, int lane) {
    const int k0 = 64 * kb, n0 = 32 * nb;
#pragma unroll 8
    for (int i = 0; i < 32; ++i) { const int kk = 2 * i + (lane >> 5); const float s = ks ? ks[k0 + kk] : 1.0f; scr[kk * 33 + (lane & 31)] = __builtin_nontemporal_load(W + (size_t)(k0 + kk) * N + n0 + (lane & 31)) * s; }
    LDS_WAIT(); asm volatile("" ::: "memory");
    const int c = lane & 7;
#pragma unroll
    for (int j = 0; j < 4; ++j) { const int n = (lane >> 3) + 8 * j; const LAS float* s = scr + (8 * c) * 33 + n;
        v4u o; o.x = pk2(s[0 * 33], s[1 * 33]); o.y = pk2(s[2 * 33], s[3 * 33]); o.z = pk2(s[4 * 33], s[5 * 33]); o.w = pk2(s[6 * 33], s[7 * 33]);
        *(v4u*)(WT + (size_t)(radd + n0 + n) * K + k0 + 8 * c) = o; }
    LDS_WAIT(); asm volatile("" ::: "memory");
}
struct Ptrs {
    const float *x, *norm_g, *fng, *lwin, *lcw, *lcb, *lwg, *lbg, *llam, *lwout, *swin, *swout;
    float* out; unsigned char* ws;
};
__device__ __forceinline__ void p0_prologue(const Ptrs& P, LAS unsigned char* lds, int gw, int NGW, int wave, int lane, int gtid, int GT, int part) {
    LAS float* scr = (LAS float*)(lds + wave * 16384);
    bf16* W0T = (bf16*)(P.ws + WS_W0T); bf16* WO0T = (bf16*)(P.ws + WS_WO0T); bf16* W1T = (bf16*)(P.ws + WS_W1T); bf16* WO1T = (bf16*)(P.ws + WS_WO1T);
    constexpr int I0 = (D / 64) * (NIN0 / 32), I1 = (LW / 64) * (D / 32), I2 = (D / 64) * (NIN1 / 32), I3 = (AW / 64) * (D / 32);
    const int it_lo = part == 2 ? I0 + I1 : 0, it_hi = part == 1 ? I0 + I1 : I0 + I1 + I2 + I3;
    for (int it = it_lo + gw; it < it_hi; it += NGW) {
        int r = it;
        if (r < I0) { const int nblk = NIN0 / 32; p0_transpose_item(P.lwin, D, NIN0, W0T, P.norm_g, 0, scr, r / nblk, r % nblk, lane); continue; } r -= I0;
        if (r < I1) { const int nblk = D / 32; p0_transpose_item(P.lwout, LW, D, WO0T, nullptr, 0, scr, r / nblk, r % nblk, lane); continue; } r -= I1;
        if (r < I2) { const int nblk = NIN1 / 32, nb = r % nblk, n0 = 32 * nb;
            const int radd = (n0 < 2 * AW) ? 0 : (n0 < 3 * AW ? AW : -AW);
            p0_transpose_item(P.swin, D, NIN1, W1T, P.norm_g + D, radd, scr, r / nblk, nb, lane); continue; } r -= I2;
        { const int nblk = D / 32; p0_transpose_item(P.swout, AW, D, WO1T, nullptr, 0, scr, r / nblk, r % nblk, lane); }
    }
    if (part == 2) return;
    bf16* WGF = (bf16*)(P.ws + WS_WGF);
    for (int g = gtid; g < LH * 6 * 6 * 64; g += GT) {
        const int l = g & 63, s = (g >> 6) % 6, tile = (g / 384) % 6, hd = g / 2304, r = l & 31, hh = l >> 5;
        const int cc = 32 * (tile % 3) + r, col = tile < 3 ? cc : LB + cc; float v[8];
#pragma unroll
        for (int j = 0; j < 8; ++j) { const int ch = 16 * s + 8 * (j >> 2) + 4 * hh + (j & 3);
            v[j] = 0.0f;
            if (cc < LB) { if (s < 5) v[j] = -LOG2E * P.lwg[((size_t)hd * LB + ch) * (2 * LB) + col]; else if (j == 0 && hh == 0) v[j] = -LOG2E * P.lbg[hd * 2 * LB + col]; } }
        v4u o; o.x = pk2(v[0], v[1]); o.y = pk2(v[2], v[3]); o.z = pk2(v[4], v[5]); o.w = pk2(v[6], v[7]);
        *(v4u*)(WGF + (size_t)g * 8) = o;
    }
    float* PAR = (float*)(P.ws + WS_PAR);
    for (int g = gtid; g < LH * 8 * LB; g += GT) {
        const int ch = g % LB, row = (g / LB) % 8, hd = g / (8 * LB), c = hd * LB + ch; float v;
        if (row < 4) v = P.lcw[row * LW + c];
        else if (row == 4) v = P.lcb[c];
        else if (row == 5) v = P.lbg[hd * 2 * LB + ch];
        else if (row == 6) v = P.lbg[hd * 2 * LB + LB + ch];
        else { const float lam = P.llam[c]; v = 8.0f * LOG2E * (fminf(lam, 0.0f) - log1pf(expf(-fabsf(lam)))); }
        PAR[g] = v;
    }
    float* ssq0 = (float*)(P.ws + WS_SSQ0); float* ssq1 = (float*)(P.ws + WS_SSQ1); float* ssq2 = (float*)(P.ws + WS_SSQ2);
    for (int g = gtid; g < M; g += GT) { ssq1[g] = 0.0f; ssq2[g] = 0.0f; }
    { unsigned long long* XS = (unsigned long long*)(P.ws + WS_X); for (int g = gtid; g < M * 4 + 1024; g += GT) XS[g] = 0ull; }
    { unsigned long long* GR = (unsigned long long*)(P.ws + WS_SUM); for (int g = gtid; g < 64 * NCHUNK * LB; g += GT) GR[g] = 0ull; }
    bf16* XB = (bf16*)(P.ws + WS_XB);
    for (int m0 = gw; m0 < M; m0 += 2 * NGW) {
        f32x4 v[2][4];
#pragma unroll
        for (int q = 0; q < 2; ++q) { const int m = m0 + q * NGW; if (m < M) { const f32x4* xr = (const f32x4*)(P.x + (size_t)m * D) + lane;
#pragma unroll
            for (int j = 0; j < 4; ++j) v[q][j] = __builtin_nontemporal_load(xr + 64 * j); } }
#pragma unroll
        for (int q = 0; q < 2; ++q) { const int m = m0 + q * NGW; if (m < M) { unsigned long long* o8 = (unsigned long long*)(XB + (size_t)m * D) + lane; float s = 0.f;
#pragma unroll
            for (int j = 0; j < 4; ++j) { s += (v[q][j].x * v[q][j].x + v[q][j].y * v[q][j].y) + (v[q][j].z * v[q][j].z + v[q][j].w * v[q][j].w);
                o8[64 * j] = (unsigned long long)pk2(v[q][j].x, v[q][j].y) | ((unsigned long long)pk2(v[q][j].z, v[q][j].w) << 32); }
            s = wave_sum(s); if (lane == 0) ssq0[m] = s; } }
    }
}

constexpr int L_WGF = 0, L_PAR = 36864, L_COMP = 39424, L_HIN = 44544;
#define LRU_DPP4(ctrl) \
    "v_fmac_f32_dpp %4, %4, %0 " ctrl "\n\tv_fmac_f32_dpp %5, %5, %1 " ctrl "\n\tv_fmac_f32_dpp %6, %6, %2 " ctrl "\n\tv_fmac_f32_dpp %7, %7, %3 " ctrl "\n\t" \
    "v_mul_f32_dpp %0, %0, %0 " ctrl "\n\tv_mul_f32_dpp %1, %1, %1 " ctrl "\n\tv_mul_f32_dpp %2, %2, %2 " ctrl "\n\tv_mul_f32_dpp %3, %3, %3 " ctrl "\n\t"
__device__ __forceinline__ void lru_phase(const Ptrs& P, LAS unsigned char* lds, int G, int wave, int lane, int tid) {
    const bf16* U0 = (const bf16*)(P.ws + WS_U0); bf16* YG = (bf16*)(P.ws + WS_YG);
    const bf16* WGF = (const bf16*)(P.ws + WS_WGF); const float* PAR = (const float*)(P.ws + WS_PAR); unsigned long long* GR = (unsigned long long*)(P.ws + WS_SUM);
    const int r = lane & 31, hh = lane >> 5;
    { const int hd0 = blockIdx.x & 15;
      const v4u* src = (const v4u*)(WGF + (size_t)hd0 * 18432); LAS v4u* dst = (LAS v4u*)(lds + L_WGF);
      for (int i = tid; i < 2304; i += NT) dst[i] = src[i];
      const f32x4* ps = (const f32x4*)(PAR + hd0 * 640); LAS f32x4* pd = (LAS f32x4*)(lds + L_PAR);
      if (tid < 160) pd[tid] = ps[tid]; }
    __syncthreads();
    v2u raw[10][4];
#define LRU_LOAD_RAW(uu) do { const int bh_ = (uu) & 63, c_ = (uu) >> 6, b_ = bh_ >> 4, hd_ = bh_ & 15, tl_ = c_ * CHUNK + wave * 32 + r; \
        _Pragma("unroll") for (int tap = 0; tap < 4; ++tap) { const int tk = tl_ - 3 + tap;        \
            const bf16* tp_ = tk >= 0 ? U0 + ((size_t)(((b_ * 128 + (tk >> 5)) * 16 + hd_) * 10) * 64 + hh * 32 + (tk & 31)) * 4 : (const bf16*)(P.ws + WS_ZERO); \
            _Pragma("unroll") for (int gq = 0; gq < 10; ++gq) raw[gq][tap] = *(const v2u*)(tp_ + gq * 256); } \
        asm volatile("" ::: "memory"); } while (0)
    if ((int)blockIdx.x < 64 * NCHUNK) LRU_LOAD_RAW((int)blockIdx.x);
    for (int u = blockIdx.x; u < 64 * NCHUNK; u += G) {
        const int bh = u & 63, c = u >> 6, b = bh >> 4, hd = bh & 15;
        const LAS float* par = (const LAS float*)(lds + L_PAR);
        const int tloc = c * CHUNK + wave * 32 + r; const size_t trow = (size_t)b * SEQ + tloc;
        float xc[5][2][4]; bf16x8 xf[5];
        {
          __builtin_amdgcn_sched_barrier(0);
#pragma unroll
          for (int s = 0; s < 5; ++s) { unsigned pkd[4];
#pragma unroll
              for (int half = 0; half < 2; ++half) { const int ch0 = 16 * s + 8 * half;
                  const f32x4 cb = *(const LAS f32x4*)(par + 4 * LB + ch0 + 4 * hh);
                  float a0 = cb[0], a1 = cb[1], a2 = cb[2], a3 = cb[3];
#pragma unroll
                  for (int tap = 0; tap < 4; ++tap) { const v2u rw = raw[s * 2 + half][tap];
                      const f32x4 cw = *(const LAS f32x4*)(par + tap * LB + ch0 + 4 * hh);
                      float c0 = cw[0], c1 = cw[1], c2 = cw[2], c3 = cw[3]; asm("" : "+v"(c0), "+v"(c1), "+v"(c2), "+v"(c3));
                      a0 = __builtin_fmaf(c0, bflo(rw.x), a0); a1 = __builtin_fmaf(c1, bfhi(rw.x), a1); a2 = __builtin_fmaf(c2, bflo(rw.y), a2); a3 = __builtin_fmaf(c3, bfhi(rw.y), a3); }
                  asm volatile("" : "+v"(a0), "+v"(a1), "+v"(a2), "+v"(a3));
                  xc[s][half][0] = a0; xc[s][half][1] = a1; xc[s][half][2] = a2; xc[s][half][3] = a3;
                  pkd[2 * half] = pk2(a0, a1); pkd[2 * half + 1] = pk2(a2, a3); __builtin_amdgcn_sched_barrier(0); }
              v4u t = {pkd[0], pkd[1], pkd[2], pkd[3]}; xf[s] = __builtin_bit_cast(bf16x8, t); __builtin_amdgcn_sched_barrier(0); } }
        float Av[5][2][4];
        const v4u xone_u = {hh == 0 ? 0x3F80u : 0u, 0u, 0u, 0u}; const bf16x8 xone = __builtin_bit_cast(bf16x8, xone_u);
#pragma unroll
        for (int mt = 0; mt < 3; ++mt) {
            f32x16 gr, gi;
#pragma unroll
            for (int i = 0; i < 16; ++i) { gr[i] = 0.f; gi[i] = 0.f; }
            const LAS bf16x8* wa = (const LAS bf16x8*)(lds + L_WGF) + (size_t)(mt * 6) * 64 + lane;
            const LAS bf16x8* wb = (const LAS bf16x8*)(lds + L_WGF) + (size_t)((3 + mt) * 6) * 64 + lane;
#pragma unroll
            for (int s = 0; s < 5; ++s) { gr = MFMA32(wa[s * 64], xf[s], gr); gi = MFMA32(wb[s * 64], xf[s], gi); }
            gr = MFMA32(wa[5 * 64], xone, gr); gi = MFMA32(wb[5 * 64], xone, gi);
            __builtin_amdgcn_sched_barrier(0);
#pragma unroll
            for (int i4 = 0; i4 < 4; ++i4) { if (mt == 2 && i4 >= 2) continue;
                const int s = 2 * mt + (i4 >> 1), half = i4 & 1, ch0 = 16 * s + 8 * half + 4 * hh;
                const f32x4 ls2 = *(const LAS f32x4*)(par + 7 * LB + ch0);
                float A4[4], B4[4];
#pragma unroll
                for (int q = 0; q < 4; ++q) { const int i = 4 * i4 + q;
                    const float rg = rcpf_(1.0f + ex2(gr[i])), ig = rcpf_(1.0f + ex2(gi[i]));
                    const float la2 = ls2[q] * rg, a = ex2(la2), xx = (2.0f * LN2) * la2;
                    const float poly = -xx * (1.0f + xx * (0.5f + xx * ((1.0f / 6.0f) + xx * ((1.0f / 24.0f) + xx * (1.0f / 120.0f)))));
                    const float om = (xx > -0.25f) ? poly : (1.0f - a * a);
                    A4[q] = a; B4[q] = __builtin_amdgcn_sqrtf(om) * (ig * xc[s][half][q]); }
                asm volatile("s_nop 1\n\t"
                    LRU_DPP4("row_shr:1 row_mask:0xf bank_mask:0xf") LRU_DPP4("row_shr:2 row_mask:0xf bank_mask:0xf") LRU_DPP4("row_shr:4 row_mask:0xf bank_mask:0xf")
                    LRU_DPP4("row_shr:8 row_mask:0xf bank_mask:0xf") LRU_DPP4("row_bcast:15 row_mask:0xa bank_mask:0xf")
                    : "+v"(A4[0]), "+v"(A4[1]), "+v"(A4[2]), "+v"(A4[3]), "+v"(B4[0]), "+v"(B4[1]), "+v"(B4[2]), "+v"(B4[3]));
#pragma unroll
                for (int q = 0; q < 4; ++q) { Av[s][half][q] = A4[q]; xc[s][half][q] = B4[q]; }
                __builtin_amdgcn_sched_barrier(0); }
        }
        v2u graw_[10];
        { const bf16* gp = U0 + (size_t)M * LW + ((size_t)(((b * 128 + (tloc >> 5)) * 16 + hd) * 10) * 64 + lane) * 4;
#pragma unroll
          for (int gq = 0; gq < 10; ++gq) graw_[gq] = *(const v2u*)(gp + gq * 256); }
        if (r == 31) { LAS float* cp = (LAS float*)(lds + L_COMP) + wave * 160 + 4 * hh;
#pragma unroll
            for (int s = 0; s < 5; ++s)
#pragma unroll
                for (int half = 0; half < 2; ++half) { const int ch0 = 16 * s + 8 * half;
                    *(LAS f32x4*)(cp + ch0) = (f32x4){Av[s][half][0], Av[s][half][1], Av[s][half][2], Av[s][half][3]};
                    *(LAS f32x4*)(cp + 80 + ch0) = (f32x4){xc[s][half][0], xc[s][half][1], xc[s][half][2], xc[s][half][3]}; } }
        { const int un = u + G < 64 * NCHUNK ? u + G : u; LRU_LOAD_RAW(un); }
        unsigned long long gv_early = 0ull;
        if (tid < LB && c > 0) gv_early = __hip_atomic_load(GR + ((size_t)bh * NCHUNK + (c - 1)) * LB + tid, __ATOMIC_RELAXED, __HIP_MEMORY_SCOPE_AGENT);
        __syncthreads();
        if (tid < LB) { const LAS float* cp = (const LAS float*)(lds + L_COMP) + tid;
            float Au = 1.0f, Bu = 0.0f;
#pragma unroll
            for (int w = 0; w < 8; ++w) { const float a = cp[w * 160], bb = cp[w * 160 + 80]; Bu = a * Bu + bb; Au = Au * a; }
            float h = 0.0f;
            if (c > 0) { unsigned long long* src = GR + ((size_t)bh * NCHUNK + (c - 1)) * LB + tid; unsigned long long v = gv_early; unsigned sp = 0;
                while ((unsigned)(v >> 32) != 1u && ++sp <= (1u << 22)) { __builtin_amdgcn_s_sleep(1); v = __hip_atomic_load(src, __ATOMIC_RELAXED, __HIP_MEMORY_SCOPE_AGENT); }
                h = __uint_as_float((unsigned)v); }
            __hip_atomic_store(GR + ((size_t)bh * NCHUNK + c) * LB + tid, (1ull << 32) | (unsigned long long)__float_as_uint(Au * h + Bu), __ATOMIC_RELAXED, __HIP_MEMORY_SCOPE_AGENT);
            LAS float* hp = (LAS float*)(lds + L_HIN) + tid;
#pragma unroll
            for (int w = 0; w < 8; ++w) { hp[w * 80] = h; h = cp[w * 160] * h + cp[w * 160 + 80]; } }
        __syncthreads();
        { const LAS float* hp = (const LAS float*)(lds + L_HIN) + wave * 80 + 4 * hh;
          bf16* yp = YG + trow * LW + hd * LB + 8 * hh;
#pragma unroll
          for (int s = 0; s < 5; ++s) { v2u pk[2];
#pragma unroll
              for (int half = 0; half < 2; ++half) { const int ch0 = 16 * s + 8 * half;
                  const f32x4 hin = *(const LAS f32x4*)(hp + ch0); const v2u graw = graw_[s * 2 + half];
                  const float g0 = bflo(graw.x), g1 = bfhi(graw.x), g2 = bflo(graw.y), g3 = bfhi(graw.y);
                  const float y0 = (xc[s][half][0] + Av[s][half][0] * hin[0]) * (g0 * sigmoid_(g0));
                  const float y1 = (xc[s][half][1] + Av[s][half][1] * hin[1]) * (g1 * sigmoid_(g1));
                  const float y2 = (xc[s][half][2] + Av[s][half][2] * hin[2]) * (g2 * sigmoid_(g2));
                  const float y3 = (xc[s][half][3] + Av[s][half][3] * hin[3]) * (g3 * sigmoid_(g3));
                  pk[half].x = pk2(y0, y1); pk[half].y = pk2(y2, y3); }
              const auto rx = __builtin_amdgcn_permlane32_swap(pk[0].x, pk[1].x, false, false), ry = __builtin_amdgcn_permlane32_swap(pk[0].y, pk[1].y, false, false);
              const v4u o = {rx[0], ry[0], rx[1], ry[1]};
              *(v4u*)(yp + 16 * s) = o; __builtin_amdgcn_sched_barrier(0); } }
    }
    __syncthreads();
}
__device__ __forceinline__ void attn_phase(const Ptrs& P, int gw, int NGW, int lane) {
    const bf16x8* QF = (const bf16x8*)(P.ws + WS_U1); const bf16x8* KF = QF + (size_t)M * AW / 8; const v2u* GF = (const v2u*)(KF + (size_t)M * AW / 8);
    const bf16x8* VF = (const bf16x8*)(P.ws + WS_VT); bf16* OG = (bf16*)(P.ws + WS_OG);
    const int r = lane & 31, hh = lane >> 5;
    for (int u = gw; u < BATCH * AH * (SEQ / 32); u += NGW) {
        const int qt = u & 127, bhh = u >> 7, b = bhh >> 4, h = bhh & 15;
        const size_t rowbase = (size_t)b * SEQ;
        bf16x8 qf[4], kf[4];
        { const bf16x8* qp = QF + (size_t)(bhh * 128 + qt) * 256 + lane;
#pragma unroll
          for (int ks = 0; ks < 4; ++ks) qf[ks] = qp[ks * 64]; }
        const bf16x8* kbase = KF + (size_t)bhh * 128 * 256 + lane;
        const bf16x8* vbase = VF + (size_t)bhh * 128 * 256 + lane;
        bf16x8 k1[4], k2[4], vf[2][2], v1[2][2];
        { const int q1 = qt > 0 ? qt - 1 : 0, q2 = qt > 1 ? qt - 2 : 0;
#pragma unroll
          for (int ks = 0; ks < 4; ++ks) { kf[ks] = kbase[(size_t)qt * 256 + ks * 64]; k1[ks] = kbase[(size_t)q1 * 256 + ks * 64]; k2[ks] = kbase[(size_t)q2 * 256 + ks * 64]; }
#pragma unroll
          for (int dt = 0; dt < 2; ++dt)
#pragma unroll
              for (int s = 0; s < 2; ++s) { vf[dt][s] = vbase[(size_t)qt * 256 + (dt * 2 + s) * 64]; v1[dt][s] = vbase[(size_t)q1 * 256 + (dt * 2 + s) * 64]; } }
        v2u gq_[8];
        { const v2u* gp_ = GF + (size_t)(bhh * 128 + qt) * 512 + lane;
#pragma unroll
          for (int j = 0; j < 8; ++j) gq_[j] = gp_[j * 64]; }
        f32x16 o0, o1;
#pragma unroll
        for (int i = 0; i < 16; ++i) { o0[i] = 0.f; o1[i] = 0.f; }
        float Pc = 1.0f;
        for (int kt = qt; kt >= 0; --kt) {
            bf16x8 k3[4], v2[2][2];
            { const int t3 = kt > 2 ? kt - 3 : 0, t2 = kt > 1 ? kt - 2 : 0;
#pragma unroll
              for (int ks = 0; ks < 4; ++ks) k3[ks] = kbase[(size_t)t3 * 256 + ks * 64];
#pragma unroll
              for (int dt = 0; dt < 2; ++dt)
#pragma unroll
                  for (int s = 0; s < 2; ++s) v2[dt][s] = vbase[(size_t)t2 * 256 + (dt * 2 + s) * 64]; }
            f32x16 sa;
#pragma unroll
            for (int i = 0; i < 16; ++i) sa[i] = 0.f;
#pragma unroll
            for (int ks = 0; ks < 4; ++ks) sa = MFMA32(kf[ks], qf[ks], sa);
            float beta[16], f[16];
            const bool diag = (kt == qt);
#pragma unroll
            for (int i = 0; i < 16; ++i) { float ff = rcpf_(1.0f + ex2(sa[i])), bt = 1.0f - ff;
                if (diag) { const bool valid = crow(i, hh) < r; bt = valid ? bt : 0.0f; ff = valid ? ff : 1.0f; }
                beta[i] = bt; f[i] = ff; }
            float gp[4], ot[4], pr[4];
#pragma unroll
            for (int g = 0; g < 4; ++g) { gp[g] = (f[4 * g] * f[4 * g + 1]) * (f[4 * g + 2] * f[4 * g + 3]);
                const auto rr = __builtin_amdgcn_permlane32_swap(__float_as_uint(gp[g]), __float_as_uint(gp[g]), false, false);
                ot[g] = __uint_as_float(rr[1]); pr[g] = __uint_as_float(rr[0]) * __uint_as_float(rr[1]); }
            float suf = Pc; float att[16];
#pragma unroll
            for (int g = 3; g >= 0; --g) { float p = (hh == 0) ? suf * ot[g] : suf;
                att[4 * g + 3] = beta[4 * g + 3] * p; p *= f[4 * g + 3];
                att[4 * g + 2] = beta[4 * g + 2] * p; p *= f[4 * g + 2];
                att[4 * g + 1] = beta[4 * g + 1] * p; p *= f[4 * g + 1];
                att[4 * g] = beta[4 * g] * p;
                suf *= pr[g]; }
            Pc = suf;
#pragma unroll
            for (int i = 0; i < 16; ++i) asm("" : "+v"(att[i]));
            bf16x8 pf[2];
#pragma unroll
            for (int s = 0; s < 2; ++s) { v4u t; t.x = pk2(att[8 * s], att[8 * s + 1]); t.y = pk2(att[8 * s + 2], att[8 * s + 3]); t.z = pk2(att[8 * s + 4], att[8 * s + 5]); t.w = pk2(att[8 * s + 6], att[8 * s + 7]); pf[s] = __builtin_bit_cast(bf16x8, t); }
#pragma unroll
            for (int s = 0; s < 2; ++s) { o0 = MFMA32(vf[0][s], pf[s], o0); o1 = MFMA32(vf[1][s], pf[s], o1); }
#pragma unroll
            for (int ks = 0; ks < 4; ++ks) { kf[ks] = k1[ks]; k1[ks] = k2[ks]; k2[ks] = k3[ks]; }
#pragma unroll
            for (int dt = 0; dt < 2; ++dt)
#pragma unroll
                for (int s = 0; s < 2; ++s) { vf[dt][s] = v1[dt][s]; v1[dt][s] = v2[dt][s]; }
            if (__builtin_amdgcn_ballot_w64(Pc != 0.0f) == 0ull) break;
        }
        const size_t row = rowbase + qt * 32 + r;
        bf16* op = OG + row * AW + h * HD + 8 * hh;
#pragma unroll
        for (int dt = 0; dt < 2; ++dt)
#pragma unroll
            for (int g = 0; g < 4; g += 2) { v2u pk[2];
#pragma unroll
                for (int e = 0; e < 2; ++e) { const v2u graw = gq_[dt * 4 + g + e]; const int i0 = 4 * (g + e);
                    const float g0 = bflo(graw.x), g1 = bfhi(graw.x), g2 = bflo(graw.y), g3 = bfhi(graw.y);
                    const float v0 = dt ? o1[i0] : o0[i0], v1 = dt ? o1[i0 + 1] : o0[i0 + 1], v2 = dt ? o1[i0 + 2] : o0[i0 + 2], v3 = dt ? o1[i0 + 3] : o0[i0 + 3];
                    float w0 = v0 * (g0 * sigmoid_(g0)), w1 = v1 * (g1 * sigmoid_(g1)), w2 = v2 * (g2 * sigmoid_(g2)), w3 = v3 * (g3 * sigmoid_(g3));
                    asm("" : "+v"(w0)); asm("" : "+v"(w1)); asm("" : "+v"(w2)); asm("" : "+v"(w3));
                    pk[e].x = pk2(w0, w1); pk[e].y = pk2(w2, w3); }
                const auto rx = __builtin_amdgcn_permlane32_swap(pk[0].x, pk[1].x, false, false), ry = __builtin_amdgcn_permlane32_swap(pk[0].y, pk[1].y, false, false);
                const v4u o = {rx[0], ry[0], rx[1], ry[1]};
                *(v4u*)(op + dt * 32 + 8 * g) = o; }
    }
}

__device__ __forceinline__ void final_norm(const Ptrs& P, int gw, int NGW, int lane) {
    const float* ssq2 = (const float*)(P.ws + WS_SSQ2);
    f32x4 g[4];
#pragma unroll
    for (int j = 0; j < 4; ++j) g[j] = ((const f32x4*)P.fng)[lane + 64 * j];
    for (int m = gw; m < M; m += NGW) { f32x4* xr = (f32x4*)(P.out + (size_t)m * D) + lane;
        const float rs = __builtin_amdgcn_rsqf(ssq2[m] * (1.0f / 1024.0f) + 1e-6f);
#pragma unroll
        for (int j = 0; j < 4; ++j) { const f32x4 v = xr[64 * j]; xr[64 * j] = v * rs * g[j]; } }
}

#define XB_TMO      128
#define XB_XCNT(j)  (256  + 64 * (j))
#define XB_XSUB(j)  (1280 + 64 * (j))
#define XB_XGEN(j)  (2304 + 64 * (j))
#define XB_TOP      3328
#define XB_TOPGEN   3392
#define XCD_BAR_WORDS 3456
#define XB_SPIN_CAP (1u << 18)

__device__ __forceinline__ unsigned xb_ld(unsigned* p)              { return __hip_atomic_load(p, __ATOMIC_RELAXED, __HIP_MEMORY_SCOPE_AGENT); }
__device__ __forceinline__ unsigned xb_add(unsigned* p, unsigned v) { return __hip_atomic_fetch_add(p, v, __ATOMIC_RELAXED, __HIP_MEMORY_SCOPE_AGENT); }
__device__ __forceinline__ unsigned xb_xcc_id() { return (unsigned)__builtin_amdgcn_s_getreg((3 << 11) | 20) & 0xFu; }
#define XB_SPIN(cond, bar) do { unsigned _sp = 0; while (cond) { __builtin_amdgcn_s_sleep(1); \
    if ((++_sp & 255u) == 0u) { if (xb_ld(&(bar)[XB_TMO])) break; if (_sp > XB_SPIN_CAP) { atomicAdd(&(bar)[XB_TMO], 1u); break; } } } } while (0)

struct XcdBarrier {
    unsigned* bar; unsigned x;
    volatile LAS unsigned* st;
};

__device__ __forceinline__ XcdBarrier xcd_barrier_post(unsigned* bar, volatile LAS unsigned* st) {
    XcdBarrier b; b.bar = bar; b.x = xb_xcc_id(); b.st = st;
    if (threadIdx.x == 0) (void)xb_add(&bar[XB_XCNT(b.x)], 1u);
    return b;
}
__device__ __forceinline__ void xcd_barrier_complete(unsigned* bar, unsigned x, unsigned& nloc, unsigned& nx) {
    const unsigned G = gridDim.x * gridDim.y * gridDim.z;
    unsigned sum, cnt, mine, sp = 0u;
    for (;;) {
        sum = 0u; cnt = 0u; mine = 0u;
#pragma unroll
        for (unsigned j = 0; j < 16; ++j) { const unsigned c = xb_ld(&bar[XB_XCNT(j)]); sum += c; cnt += (c > 0u) ? 1u : 0u; mine = (j == x) ? c : mine; }
        if (sum == G) break;
        __builtin_amdgcn_s_sleep(1);
        if ((++sp & 255u) == 0u) { if (xb_ld(&bar[XB_TMO])) break; if (sp > XB_SPIN_CAP) { atomicAdd(&bar[XB_TMO], 1u); break; } }
    }
    nloc = mine > 0u ? mine : 1u; nx = cnt > 0u ? cnt : 1u;
}

__device__ __forceinline__ void xcd_barrier(const XcdBarrier& b) {
    asm volatile("s_waitcnt vmcnt(0)" ::: "memory");
    __syncthreads();
    if (threadIdx.x == 0) {
        unsigned* bar = b.bar;
        __builtin_amdgcn_s_waitcnt(0);
        unsigned nloc = b.st[0], nx = b.st[1];
        if (nloc == 0u) { xcd_barrier_complete(bar, b.x, nloc, nx); b.st[0] = nloc; b.st[1] = nx; }
        const unsigned old = xb_add(&bar[XB_XSUB(b.x)], 1u);
        const unsigned gen = old / nloc;
        if (old + 1u == (gen + 1u) * nloc) {
            __builtin_amdgcn_fence(__ATOMIC_RELEASE, "agent");
            asm volatile("s_waitcnt vmcnt(0)" ::: "memory");
            const unsigned og = xb_add(&bar[XB_TOP], 1u);
            const unsigned tg = og / nx;
            if (og + 1u == (tg + 1u) * nx) xb_add(&bar[XB_TOPGEN], 1u);
            else XB_SPIN(xb_ld(&bar[XB_TOPGEN]) == tg, bar);
            __builtin_amdgcn_fence(__ATOMIC_ACQUIRE, "agent");
            xb_add(&bar[XB_XGEN(b.x)], 1u);
            asm volatile("s_waitcnt vmcnt(0)" ::: "memory");
        } else {
            XB_SPIN(xb_ld(&bar[XB_XGEN(b.x)]) == gen, bar);
            __builtin_amdgcn_fence(__ATOMIC_ACQUIRE, "agent");
            asm volatile("s_waitcnt vmcnt(0)" ::: "memory");
        }
    }
    __syncthreads();
}

struct Args { Ptrs p; int ph_lo, ph_hi, cg_seam0, pad; };
__global__ void __launch_bounds__(NT, 2) trunk_fwd(Args args) {
    extern __shared__ __attribute__((aligned(16))) unsigned char lds_raw[];
    LAS unsigned char* lds = (LAS unsigned char*)lds_raw;
    cg::grid_group grid = cg::this_grid();
    const Ptrs& P = args.p;
    const int tid = threadIdx.x, lane = tid & 63, wave = __builtin_amdgcn_readfirstlane(tid >> 6);
    const int G = gridDim.x, gw = blockIdx.x * NWAVES + wave, NGW = G * NWAVES, gtid = blockIdx.x * NT + tid, GT = G * NT;
    const int lo = args.ph_lo, hi = args.ph_hi;
#define IN(k) (lo <= (k) && (k) < hi)
    if (tid < 8) ((volatile LAS unsigned*)(lds + 131072))[tid] = 0u;
    __syncthreads();
    XcdBarrier bar = xcd_barrier_post((unsigned*)P.ws, (volatile LAS unsigned*)(lds + 131072));
#define SEAM(k) do { if (IN(k) && IN((k) + 1)) { if ((k) == 0 && args.cg_seam0) grid.sync(); else xcd_barrier(bar); } } while (0)
    unsigned char* ws = P.ws;
    const bool split_p0 = (G == 256) && IN(0) && IN(1);
    if (IN(0)) { p0_prologue(P, lds, gw, NGW, wave, lane, gtid, GT, split_p0 ? 1 : 0); __syncthreads(); }
    SEAM(0);
    if (IN(1)) {
        pg8::Gemm g{(const bf16*)(ws + WS_XB), (const bf16*)(ws + WS_W0T), M, NIN0, D}; pg8::StaticOrder S; S.init(M, NIN0, G, (int)blockIdx.x);
        pg8::EpiLruIn E{(bf16*)(ws + WS_U0), (const float*)(ws + WS_SSQ0)};
        pg8::gemm_phase<pg8::EpiLruIn, pg8::StaticOrder, true, true>(lds, g, S, E);
        if (split_p0 && blockIdx.x >= 128) { __syncthreads(); p0_prologue(P, lds, (blockIdx.x - 128) * NWAVES + wave, 128 * NWAVES, wave, lane, 0, 1, 2); __syncthreads(); }
    }
    SEAM(1);
    if (IN(2)) lru_phase(P, lds, G, wave, lane, tid);
    if (IN(2) && IN(4)) xcd_barrier(bar);
    if (IN(4)) {
        pg8::Gemm g{(const bf16*)(ws + WS_YG), (const bf16*)(ws + WS_WO0T), M, D, LW}; pg8::StaticOrder S; S.init(M, D, G, (int)blockIdx.x);
        pg8::EpiResidB E{(const bf16*)(ws + WS_XB), (bf16*)(ws + WS_XB), (float*)(ws + WS_SSQ1), D};
        pg8::gemm_phase<pg8::EpiResidB, pg8::StaticOrder, false, true>(lds, g, S, E);
    }
    SEAM(4);
    if (IN(5)) {
        { pg8::Gemm g{(const bf16*)(ws + WS_XB), (const bf16*)(ws + WS_W1T), M, NQKG, D}; pg8::StaticOrder S; S.init(M, NQKG, G, (int)blockIdx.x);
          pg8::EpiQKG E{(bf16*)(ws + WS_U1), (const float*)(ws + WS_SSQ1), QSCALE};
          pg8::gemm_phase<pg8::EpiQKG, pg8::StaticOrder, true, true>(lds, g, S, E); }
        { pg8::Gemm g{(const bf16*)(ws + WS_W1T) + (size_t)NQKG * D, (const bf16*)(ws + WS_XB), AW, M, D}; pg8::StaticOrder S; S.init(AW, M, G, (int)blockIdx.x);
          pg8::EpiVF E{(bf16*)(ws + WS_VT), (const float*)(ws + WS_SSQ1)};
          pg8::gemm_phase<pg8::EpiVF, pg8::StaticOrder, false, true>(lds, g, S, E); }
    }
    SEAM(5);
    if (IN(6)) attn_phase(P, gw, NGW, lane);
    SEAM(6);
    if (IN(7)) {
        pg8::Gemm g{(const bf16*)(ws + WS_OG), (const bf16*)(ws + WS_WO1T), M, D, AW}; pg8::StaticOrder S; S.init(M, D, G, (int)blockIdx.x);
        if (G == 256) {
            pg8::EpiResidNorm E{(const bf16*)(ws + WS_XB), P.out, P.fng, (unsigned long long*)(ws + WS_X), D};
            pg8::gemm_phase<pg8::EpiResidNorm, pg8::StaticOrder, false, true>(lds, g, S, E);
        } else {
            pg8::EpiResid<true, true, false> E{(const void*)(ws + WS_XB), P.out, nullptr, (float*)(ws + WS_SSQ2), D};
            pg8::gemm_phase<pg8::EpiResid<true, true, false>, pg8::StaticOrder, false, true>(lds, g, S, E);
            xcd_barrier(bar);
            final_norm(P, gw, NGW, lane);
        }
    }
#undef IN
#undef SEAM
}

extern "C" void kernel_launch(void* const* d_in, const int* in_sizes, int n_in, void* d_out, int out_size, void* d_ws, size_t ws_size, hipStream_t stream) {
    static int grid = 0;
    if (grid == 0) {
        if (n_in != 12 || in_sizes[0] != M * D || out_size != M * D || ws_size < WS_END) { fprintf(stderr, "kernel_launch: unexpected shapes (n_in %d, in0 %d, out %d, ws %zu)\n", n_in, n_in > 0 ? in_sizes[0] : -1, out_size, ws_size); grid = -1; return; }
        int dev = 0, cus = 0, per_cu = 0;
        hipGetDevice(&dev); hipDeviceGetAttribute(&cus, hipDeviceAttributeMultiprocessorCount, dev);
        hipFuncSetAttribute((const void*)trunk_fwd, hipFuncAttributeMaxDynamicSharedMemorySize, LDS_BYTES);
        hipOccupancyMaxActiveBlocksPerMultiprocessor(&per_cu, (const void*)trunk_fwd, NT, LDS_BYTES);
        if (per_cu < 1) { fprintf(stderr, "kernel_launch: occupancy query reports %d workgroups per CU\n", per_cu); per_cu = 1; }
        (void)hipGetLastError();
        grid = (cus / 64) * 64;
        fprintf(stderr, "kernel_launch: grid %d (cus %d, per_cu %d)\n", grid, cus, per_cu);
    }
    if (grid < 0) return;
    Args a{};
    a.p.x = (const float*)d_in[0]; a.p.norm_g = (const float*)d_in[1]; a.p.fng = (const float*)d_in[2]; a.p.lwin = (const float*)d_in[3];
    a.p.lcw = (const float*)d_in[4]; a.p.lcb = (const float*)d_in[5]; a.p.lwg = (const float*)d_in[6]; a.p.lbg = (const float*)d_in[7];
    a.p.llam = (const float*)d_in[8]; a.p.lwout = (const float*)d_in[9]; a.p.swin = (const float*)d_in[10]; a.p.swout = (const float*)d_in[11];
    a.p.out = (float*)d_out; a.p.ws = (unsigned char*)d_ws;
    a.ph_lo = 0; a.ph_hi = 9; a.cg_seam0 = 0;
    if (hipMemsetAsync(d_ws, 0, 16384, stream) != hipSuccess) { fprintf(stderr, "kernel_launch: memset of the barrier words failed\n"); return; }
    void* kargs[] = {&a};
    hipError_t e = hipLaunchCooperativeKernel((const void*)trunk_fwd, dim3(grid), dim3(NT), kargs, LDS_BYTES, stream);
    if (e != hipSuccess) fprintf(stderr, "cooperative launch failed: %s (grid %d)\n", hipGetErrorString(e), grid);
}
```
